# Optimizing an MI355X kernel written in HIP

```python
import jax, jax.numpy as jnp
from jax import lax
import numpy as np

D_MODEL = 2048
BATCH = 4
SEQ = 2048
DEPTH = 1

GDN_HEADS = 16
GDN_HEAD_K = 128
GDN_HEAD_V = 128
GDN_CONV = 4
GDN_CHUNK = 64
QK_W = GDN_HEADS * GDN_HEAD_K
V_W = GDN_HEADS * GDN_HEAD_V
SC_WIDTH = 2048
SC_CONV = 3
D_FF = -(-8 * D_MODEL // (3 * 256)) * 256
EPS = 1e-6

IN_SIZES = (QK_W, QK_W, V_W, V_W, GDN_HEADS, GDN_HEADS, SC_WIDTH, SC_WIDTH, SC_WIDTH, D_MODEL, D_MODEL)
IN_WIDTH = sum(IN_SIZES)

kernel_name = "hybrid_gdn_shortconv_gated_merge"


def rms_norm(x, g):
    xf = x.astype(jnp.float32)
    y = xf * lax.rsqrt(jnp.mean(xf * xf, axis=-1, keepdims=True) + EPS)
    return (y * g.astype(jnp.float32)).astype(x.dtype)


def l2_norm(x):
    return x * lax.rsqrt(jnp.sum(x * x, axis=-1, keepdims=True) + EPS)


def partition(t, sizes):
    out, start = [], 0
    for s in sizes:
        out.append(t[..., start:start + s])
        start += s
    return out


def causal_dwconv(x, w):
    K = w.shape[0]
    T = x.shape[1]
    xp = jnp.pad(x, ((0, 0), (K - 1, 0), (0, 0)))
    y = xp[:, 0:T] * w[0]
    for i in range(1, K):
        y = y + xp[:, i:i + T] * w[i]
    return y


def gated_delta_chunked(q, k, v, g, beta):
    Bn, T, H, Dk = q.shape
    Dv = v.shape[-1]
    C = GDN_CHUNK
    N = T // C

    def to_chunks(t):
        t = jnp.moveaxis(t, 2, 1)
        return t.reshape(t.shape[:2] + (N, C) + t.shape[3:])

    q, k, v, g, beta = map(to_chunks, (q * (Dk ** -0.5), k, v, g, beta))
    g = jnp.cumsum(g, axis=-1)
    causal = jnp.tril(jnp.ones((C, C), dtype=bool))
    strict = jnp.tril(jnp.ones((C, C), dtype=bool), -1)
    decay = jnp.exp(jnp.where(causal, g[..., :, None] - g[..., None, :], -jnp.inf))
    k_beta = k * beta[..., None]
    a_low = jnp.where(strict, jnp.einsum('bhnid,bhnjd->bhnij', k_beta, k) * decay, 0.0)
    t_mat = a_low + jnp.eye(C, dtype=a_low.dtype)
    rhs = jnp.concatenate([v * beta[..., None], k_beta * jnp.exp(g)[..., None]], axis=-1)
    sol = lax.linalg.triangular_solve(t_mat, rhs, left_side=True, lower=True, unit_diagonal=True)
    u, w = sol[..., :Dv], sol[..., Dv:]
    attn_intra = jnp.einsum('bhnid,bhnjd->bhnij', q, k) * decay
    q_dec = q * jnp.exp(g)[..., None]
    g_last = g[..., -1]
    k_dec = k * jnp.exp(g_last[..., None] - g)[..., None]

    def step(S, xs):
        q_c, k_c, u_c, w_c, attn_c, gl_c = xs
        v_new = u_c - jnp.einsum('bhcd,bhdv->bhcv', w_c, S)
        o = jnp.einsum('bhcd,bhdv->bhcv', q_c, S) + jnp.einsum('bhij,bhjv->bhiv', attn_c, v_new)
        S = S * jnp.exp(gl_c)[..., None, None] + jnp.einsum('bhcd,bhcv->bhdv', k_c, v_new)
        return S, o

    xs = tuple(jnp.moveaxis(t, 2, 0) for t in (q_dec, k_dec, u, w, attn_intra, g_last))
    S0 = jnp.zeros((Bn, H, Dk, Dv), dtype=jnp.float32)
    _, o = lax.scan(step, S0, xs)
    o = jnp.moveaxis(o, 0, 2).reshape(Bn, H, T, Dv)
    return jnp.moveaxis(o, 1, 2)


def gdn_branch(q, k, v, z, b, a, conv_w, A_log, dt_bias, norm_g):
    Bn, T, _ = q.shape
    dtype = q.dtype
    qkv = jax.nn.silu(causal_dwconv(jnp.concatenate([q, k, v], axis=-1), conv_w))
    q, k, v = partition(qkv.astype(jnp.float32), (QK_W, QK_W, V_W))
    q = l2_norm(q.reshape(Bn, T, GDN_HEADS, GDN_HEAD_K))
    k = l2_norm(k.reshape(Bn, T, GDN_HEADS, GDN_HEAD_K))
    v = v.reshape(Bn, T, GDN_HEADS, GDN_HEAD_V)
    beta = jax.nn.sigmoid(b.astype(jnp.float32))
    g = -jnp.exp(A_log.astype(jnp.float32)) * jax.nn.softplus(a.astype(jnp.float32) + dt_bias.astype(jnp.float32))
    o = gated_delta_chunked(q, k, v, g, beta)
    o = rms_norm(o, norm_g) * jax.nn.silu(z.reshape(Bn, T, GDN_HEADS, GDN_HEAD_V).astype(jnp.float32))
    return o.reshape(Bn, T, V_W).astype(dtype)


def setup_inputs(seed: int = 0) -> dict:
    key = jax.random.key(seed)
    ks = jax.random.split(key, 17)
    L = DEPTH
    nrm = lambda k, shape, fan_in: jax.random.normal(k, shape, jnp.float32) * (fan_in ** -0.5)
    gain = lambda k, shape: 1.0 + 0.02 * jax.random.normal(k, shape, jnp.float32)
    return {
        "x": jax.random.normal(ks[0], (BATCH, SEQ, D_MODEL), jnp.float32),
        "ln_mix_g": gain(ks[1], (L, D_MODEL)),
        "w_in": nrm(ks[2], (L, D_MODEL, IN_WIDTH), D_MODEL),
        "conv_qkv_w": nrm(ks[3], (L, GDN_CONV, 2 * QK_W + V_W), GDN_CONV),
        "A_log": jnp.log(jax.random.uniform(ks[4], (L, GDN_HEADS), jnp.float32, 1.0, 16.0)),
        "dt_bias": 0.1 * jax.random.normal(ks[5], (L, GDN_HEADS), jnp.float32),
        "gdn_norm_g": gain(ks[6], (L, GDN_HEAD_V)),
        "w_proj_a": nrm(ks[7], (L, V_W, D_MODEL), V_W),
        "conv_sc_w": nrm(ks[8], (L, SC_CONV, SC_WIDTH), SC_CONV),
        "w_proj_b": nrm(ks[9], (L, SC_WIDTH, D_MODEL), SC_WIDTH),
        "w_out": nrm(ks[10], (L, D_MODEL, D_MODEL), D_MODEL),
        "ln_ffn_g": gain(ks[11], (L, D_MODEL)),
        "w_gate": nrm(ks[12], (L, D_MODEL, D_FF), D_MODEL),
        "w_up": nrm(ks[13], (L, D_MODEL, D_FF), D_MODEL),
        "w_down": nrm(ks[14], (L, D_FF, D_MODEL), D_FF),
        "ln_final_g": gain(ks[15], (D_MODEL,)),
    }


def reference(x, ln_mix_g, w_in, conv_qkv_w, A_log, dt_bias, gdn_norm_g, w_proj_a, conv_sc_w,
              w_proj_b, w_out, ln_ffn_g, w_gate, w_up, w_down, ln_final_g):
    h = x
    for l in range(DEPTH):
        xn = rms_norm(h, ln_mix_g[l])
        proj = jnp.einsum('btd,de->bte', xn, w_in[l])
        q, k, v, z, b, a, sc_b, sc_c, sc_h, gate_a, gate_b = partition(proj, IN_SIZES)
        o_a = gdn_branch(q, k, v, z, b, a, conv_qkv_w[l], A_log[l], dt_bias[l], gdn_norm_g[l])
        o_b = sc_b * causal_dwconv(sc_c * sc_h, conv_sc_w[l])
        merged = (jax.nn.sigmoid(gate_a) * jnp.einsum('btv,vd->btd', o_a, w_proj_a[l])
                  + jax.nn.sigmoid(gate_b) * jnp.einsum('btc,cd->btd', o_b, w_proj_b[l]))
        h = h + jnp.einsum('btd,de->bte', merged, w_out[l])
        hn = rms_norm(h, ln_ffn_g[l])
        ff = jax.nn.silu(jnp.einsum('btd,df->btf', hn, w_gate[l])) * jnp.einsum('btd,df->btf', hn, w_up[l])
        h = h + jnp.einsum('btf,fd->btd', ff, w_down[l])
    return rms_norm(h, ln_final_g)
```

```cpp
#include <hip/hip_runtime.h>
#include <hip/hip_cooperative_groups.h>
#include <cstdio>
namespace cg = cooperative_groups;
#define N_LAUNCHES 1
#define TRUNC_MASK 0
namespace pg8 {
#define PG8_LAS __attribute__((address_space(3)))
typedef unsigned short bf16_t;
typedef short bf16x8 __attribute__((ext_vector_type(8)));
typedef float f32x4 __attribute__((ext_vector_type(4)));
typedef unsigned u32x4 __attribute__((ext_vector_type(4)));
constexpr int BM = 256, BK = 64, HALF = 128, HTB = HALF * BK * 2  , STAGE_BYTES = 8 * HTB, NXCD = 8, WGM = 8;

__host__ __device__ __forceinline__ int lds_byte(int r, int c) { const int st = (r >> 4) * 2 + (c >> 5), rr = r & 15, cc = c & 31, ob = rr * 64 + cc * 2; return st * 1024 + (ob ^ (((ob >> 9) & 1) << 5)); }
__host__ __device__ __forceinline__ void stage_rc(int b, int& R, int& C) { const int st = b / 1024, sb = b % 1024, swz = sb ^ (((sb >> 9) & 1) << 5); R = (st >> 1) * 16 + swz / 64; C = (st & 1) * 32 + (swz % 64) / 2; }
__host__ __device__ __forceinline__ int perm32(int rho) { const int n = rho >> 4, i = rho & 15; return 8 * (i >> 2) + 4 * n + (i & 3); }

struct Unit { int pm, pn; };
struct Gemm { const bf16_t* A; const bf16_t* Bt; int M, N, K, lda; };

struct StaticOrder {
    int nM, nN, nwg, G, c;
    __host__ __device__ void init(int M, int N, int G_, int c_) { nM = M / BM; nN = N / BM; nwg = nM * nN; G = G_; c = c_; }
    __host__ __device__ bool next(int i, Unit& u) const {
        const long L = (long)i * G + c; if (L >= nwg) return false;
        int wgid = (int)L; { const int q = nwg / NXCD, r = nwg % NXCD, xcd = wgid % NXCD, off = wgid / NXCD; wgid = (xcd < r ? xcd * (q + 1) : r * (q + 1) + (xcd - r) * q) + off; }
        const int nig = WGM * nN, gid = wgid / nig, fm = gid * WGM, gsz = (nM - fm) < WGM ? (nM - fm) : WGM;
        u.pm = fm + ((wgid % nig) % gsz); u.pn = (wgid % nig) / gsz; return true;
    }
    __device__ __forceinline__ void a_ready(const Unit&) const {}
    __device__ __forceinline__ void done(const Unit&) const {}
};
__device__ __forceinline__ unsigned cvt_pk_bf16(float lo, float hi) { unsigned r; asm volatile("v_cvt_pk_bf16_f32 %0, %1, %2" : "=v"(r) : "v"(lo), "v"(hi)); return r; }
template <class Epi, class Sched, bool STAMP = false>
__device__ __forceinline__ void gemm_phase(PG8_LAS unsigned char* lds, const Gemm g, const Sched& S, const Epi& E, unsigned long long* stamps) {
    const int tid = threadIdx.x, wid = __builtin_amdgcn_readfirstlane(tid >> 6), lane = tid & 63, wr = wid >> 2, wc = wid & 3, fr = lane & 15, fq = lane >> 4;
    const int K = g.K, nt = K / BK;
    int ts_lo = 0, ts_hi = 0, nts = 0; const unsigned long long rt_entry = STAMP ? (unsigned long long)wall_clock64() : 0ull;
#define PG8_STAMP() do { if (STAMP && wid == 0 && nts < 64) { const unsigned long long _c = (unsigned long long)clock64(); \
        ts_lo = (lane == nts) ? (int)(unsigned)_c : ts_lo; ts_hi = (lane == nts) ? (int)(unsigned)(_c >> 32) : ts_hi; ++nts; } } while (0)
    PG8_STAMP();
    unsigned voffA[2], voffB[2];
#pragma unroll
    for (int i = 0; i < 2; ++i) { int R, C; stage_rc(tid * 16 + i * 8192, R, C); const int Rb = Epi::PERM ? ((R & ~31) + perm32(R & 31)) : R;
        voffA[i] = (unsigned)(R * g.lda + C) * 2u; voffB[i] = (unsigned)(Rb * K + C) * 2u; }
    const size_t kstep = (size_t)(BK * 2);
    const size_t hstepA = (size_t)HALF * g.lda * 2, hstepB = (size_t)HALF * K * 2;
    const size_t tstepA = 2 * hstepA, tstepB = 2 * hstepB;
    const unsigned ldsw = (unsigned)wid * 1024u;
    const int aoff = lds_byte(wr * 64 + fr, fq * 8), boff = lds_byte(wc * 32 + fr, fq * 8);
#define PG8_SA(b, h) (((b) * 2 + (h)) * HTB)
#define PG8_SB(b, h) ((4 + (b) * 2 + (h)) * HTB)
#define PG8_STAGE(bufoff, gbase, voff) do { _Pragma("unroll") for (int _i = 0; _i < 2; ++_i) \
        __builtin_amdgcn_global_load_lds((const unsigned*)((const char*)(gbase) + (voff)[_i]), (PG8_LAS unsigned*)(lds + (bufoff) + ldsw + _i * 8192), 16, 0, 0); } while (0)
#define PG8_LDA(dst, b, h) do { _Pragma("unroll") for (int m = 0; m < 4; ++m) _Pragma("unroll") for (int k = 0; k < 2; ++k) dst[m][k] = *(const PG8_LAS bf16x8*)(lds + PG8_SA(b, h) + aoff + m * 2048 + k * 1024); } while (0)
#define PG8_LDB(dst, b, h) do { _Pragma("unroll") for (int n = 0; n < 2; ++n) _Pragma("unroll") for (int k = 0; k < 2; ++k) dst[n][k] = *(const PG8_LAS bf16x8*)(lds + PG8_SB(b, h) + boff + n * 2048 + k * 1024); } while (0)
#define PG8_MMA(ai, bj, At, Bt) do { __builtin_amdgcn_s_setprio(1); _Pragma("unroll") for (int m = 0; m < 4; ++m) _Pragma("unroll") for (int n = 0; n < 2; ++n) _Pragma("unroll") for (int k = 0; k < 2; ++k) \
        acc[ai][bj][m][n] = __builtin_amdgcn_mfma_f32_16x16x32_bf16(Bt[n][k], At[m][k], acc[ai][bj][m][n], 0, 0, 0); __builtin_amdgcn_s_setprio(0); } while (0)
#define PG8_WAIT_V(n) asm volatile("s_waitcnt vmcnt(" #n ")" ::: "memory")
#define PG8_WAIT_L(n) asm volatile("s_waitcnt lgkmcnt(" #n ")" ::: "memory")
#define PG8_BAR __builtin_amdgcn_s_barrier()
#define PG8_SCHED __builtin_amdgcn_sched_barrier(0)
    Unit cur, nxt; int ui = 0;
    if (!S.next(0, cur)) return;
    f32x4 acc[2][2][4][2];
#pragma unroll
    for (int a = 0; a < 2; ++a)
#pragma unroll
        for (int b = 0; b < 2; ++b)
#pragma unroll
            for (int m = 0; m < 4; ++m)
#pragma unroll
                for (int n = 0; n < 2; ++n) acc[a][b][m][n] = (f32x4){0.f, 0.f, 0.f, 0.f};
    bf16x8 At[4][2], B0[2][2], B1[2][2];
    const char* cA = (const char*)g.A + (size_t)cur.pm * tstepA; const char* cB = (const char*)g.Bt + (size_t)cur.pn * tstepB;
    S.a_ready(cur);
    PG8_STAGE(PG8_SB(0, 0), cB, voffB); PG8_STAGE(PG8_SA(0, 0), cA, voffA); PG8_STAGE(PG8_SB(0, 1), cB + hstepB, voffB); PG8_STAGE(PG8_SA(0, 1), cA + hstepA, voffA);
    if (wr == 1) PG8_BAR;
    PG8_WAIT_V(4); PG8_BAR;
    PG8_STAGE(PG8_SB(1, 0), cB + kstep, voffB); PG8_STAGE(PG8_SA(1, 0), cA + kstep, voffA); PG8_STAGE(PG8_SB(1, 1), cB + hstepB + kstep, voffB);
    PG8_WAIT_V(6); PG8_BAR;
    PG8_STAMP();
    for (;;) {
        const bool has_next = S.next(ui + 1, nxt);
        const char* nA = has_next ? (const char*)g.A + (size_t)nxt.pm * tstepA : cA; const char* nB = has_next ? (const char*)g.Bt + (size_t)nxt.pn * tstepB : cB;
        for (int t = 0; t < nt; t += 2) {
            const bool last = (t == nt - 2);
            const char* a1 = cA + (size_t)(t + 1) * kstep;
            const char* a2 = last ? nA : cA + (size_t)(t + 2) * kstep; const char* b2 = last ? nB : cB + (size_t)(t + 2) * kstep;
            const char* a3 = a2 + kstep; const char* b3 = b2 + kstep;
            if (last && has_next) S.a_ready(nxt);
            PG8_LDB(B0, 0, 0); PG8_SCHED; PG8_LDA(At, 0, 0); PG8_STAGE(PG8_SA(1, 1), a1 + hstepA, voffA);
            PG8_WAIT_L(8); PG8_BAR; PG8_WAIT_L(0); PG8_MMA(0, 0, At, B0); PG8_BAR; PG8_SCHED;
            PG8_LDB(B1, 0, 1); PG8_STAGE(PG8_SB(0, 0), b2, voffB);
            PG8_BAR; PG8_WAIT_L(0); PG8_MMA(0, 1, At, B1); PG8_BAR;
            PG8_LDA(At, 0, 1); PG8_STAGE(PG8_SA(0, 0), a2, voffA);
            PG8_BAR; PG8_WAIT_L(0); PG8_MMA(1, 0, At, B0); PG8_BAR; PG8_SCHED;
            PG8_STAGE(PG8_SB(0, 1), b2 + hstepB, voffB);
            PG8_WAIT_V(6); PG8_BAR; PG8_MMA(1, 1, At, B1); PG8_BAR;
            PG8_LDB(B0, 1, 0); PG8_SCHED; PG8_LDA(At, 1, 0); PG8_STAGE(PG8_SA(0, 1), a2 + hstepA, voffA);
            PG8_WAIT_L(8); PG8_BAR; PG8_WAIT_L(0); PG8_MMA(0, 0, At, B0); PG8_BAR; PG8_SCHED;
            PG8_LDB(B1, 1, 1); PG8_STAGE(PG8_SB(1, 0), b3, voffB);
            PG8_BAR; PG8_WAIT_L(0); PG8_MMA(0, 1, At, B1); PG8_BAR;
            PG8_LDA(At, 1, 1); PG8_STAGE(PG8_SA(1, 0), a3, voffA);
            PG8_BAR; PG8_WAIT_L(0); PG8_MMA(1, 0, At, B0); PG8_BAR; PG8_SCHED;
            PG8_STAGE(PG8_SB(1, 1), b3 + hstepB, voffB);
            PG8_WAIT_V(6); PG8_BAR; PG8_MMA(1, 1, At, B1); PG8_BAR;
        }
        PG8_STAMP();
        if constexpr (!Epi::AFTER_DRAIN) { E(acc, cur, wr, wc, fr, fq); S.done(cur); }
        PG8_STAMP();
        if (!has_next) break;
#pragma unroll
        for (int a = 0; a < 2; ++a)
#pragma unroll
            for (int b = 0; b < 2; ++b)
#pragma unroll
                for (int m = 0; m < 4; ++m)
#pragma unroll
                    for (int n = 0; n < 2; ++n) acc[a][b][m][n] = (f32x4){0.f, 0.f, 0.f, 0.f};
        cur = nxt; cA = nA; cB = nB; ++ui;
    }
    PG8_WAIT_V(0);
    if (wr == 0) PG8_BAR;
    PG8_BAR;
    if constexpr (Epi::AFTER_DRAIN) { E.fused(acc, cur, wr, wc, fr, fq, lds, wid, lane); S.done(cur); }
    PG8_STAMP();
    if (STAMP && wid == 0) { stamps[lane] = lane < nts ? (((unsigned long long)(unsigned)ts_hi << 32) | (unsigned)ts_lo) : 0ull;
        if (lane == 62) stamps[62] = rt_entry; if (lane == 63) stamps[63] = (unsigned long long)wall_clock64(); }
#undef PG8_STAMP
#undef PG8_SA
#undef PG8_SB
#undef PG8_STAGE
#undef PG8_LDA
#undef PG8_LDB
#undef PG8_MMA
#undef PG8_WAIT_V
#undef PG8_WAIT_L
#undef PG8_BAR
#undef PG8_SCHED
}
}

#define LAS __attribute__((address_space(3)))
typedef unsigned short bf16_t;
typedef short bf16x8 __attribute__((ext_vector_type(8)));
typedef float f32x4 __attribute__((ext_vector_type(4)));
typedef unsigned u32x4 __attribute__((ext_vector_type(4)));
typedef unsigned u32x2 __attribute__((ext_vector_type(2)));

constexpr int MTOK = 8192, DM = 2048, SEQ = 2048, NH = 16, DFF = 5632, INW = 18464, LDP = 18688;
constexpr int OFF_Q = 0, OFF_K = 2048, OFF_V = 4096, OFF_Z = 6144, OFF_BETA = 8192, OFF_A = 8208, OFF_SB = 8224, OFF_SC = 10272, OFF_SH = 12320, OFF_GA = 14368, OFF_GB = 16416;
constexpr float EPS = 1e-6f;
constexpr int NPHASE = 9;
#ifndef N_LAUNCHES
#define N_LAUNCHES 1
#endif

constexpr size_t HAND_UNIT = 73728;
constexpr size_t WS_A0 = 0;
constexpr size_t WS_WIN = WS_A0, WS_XN = WS_A0 + (size_t)LDP * DM * 2;
constexpr size_t WS_HAND = WS_A0, WS_MA = WS_A0, WS_MB = WS_A0 + (size_t)MTOK * DM * 4;
constexpr size_t A0_BYTES = 2048 * HAND_UNIT;
constexpr size_t WS_PROJ = WS_A0 + A0_BYTES;
constexpr size_t WS_H1F = WS_PROJ, WS_H1B = WS_PROJ + (size_t)MTOK * DM * 4, WS_FF = WS_H1B + (size_t)MTOK * DM * 2;
constexpr size_t WS_WA = WS_PROJ + (size_t)MTOK * LDP * 2;
constexpr size_t WS_WB = WS_WA + (size_t)DM * DM * 2, WS_WO = WS_WB + (size_t)DM * DM * 2, WS_WGU = WS_WO + (size_t)DM * DM * 2;
constexpr size_t WS_WD = WS_WGU + (size_t)2 * DFF * DM * 2;
constexpr size_t WS_EGL = WS_WD + (size_t)DM * DFF * 2;
constexpr size_t WS_RSQ1 = WS_EGL + 2048 * 4, WS_END = WS_RSQ1 + (size_t)MTOK * 32 * 4;
static_assert(WS_XN + (size_t)MTOK * DM * 2 <= A0_BYTES && WS_MB + (size_t)MTOK * DM * 2 <= A0_BYTES, "A0 overlays");
static_assert(WS_FF + (size_t)MTOK * DFF * 2 <= WS_WA, "proj overlays");

struct Params {
    const float *x, *ln_mix_g, *w_in, *conv_qkv_w, *A_log, *dt_bias, *gdn_norm_g, *w_proj_a, *conv_sc_w, *w_proj_b, *w_out, *ln_ffn_g, *w_gate, *w_up, *w_down, *ln_final_g;
    float* out; unsigned char* ws; int ph_lo, ph_hi;
};

__device__ __forceinline__ float bf2f(bf16_t u) { return __uint_as_float((unsigned)u << 16); }
__device__ __forceinline__ float bflo(unsigned w) { return __uint_as_float(w << 16); }
__device__ __forceinline__ float bfhi(unsigned w) { return __uint_as_float(w & 0xffff0000u); }
typedef float f32x2_t __attribute__((ext_vector_type(2)));
typedef __bf16 bf16x2_t __attribute__((ext_vector_type(2)));
__device__ __forceinline__ unsigned pk2(float lo, float hi) { const f32x2_t v = {lo, hi}; const bf16x2_t b = __builtin_convertvector(v, bf16x2_t); return __builtin_bit_cast(unsigned, b); }
#ifndef TRUNC_MASK
#define TRUNC_MASK 0
#endif
template <int K> __device__ __forceinline__ unsigned pk2x(float lo, float hi) {
    if ((TRUNC_MASK >> K) & 1) return (__float_as_uint(hi) & 0xffff0000u) | (__float_as_uint(lo) >> 16);
    return pk2(lo, hi);
}
__device__ __forceinline__ float sigmoidf_(float x) { return 1.0f / (1.0f + __expf(-x)); }
__device__ __forceinline__ float siluf_(float x) { return x / (1.0f + __expf(-x)); }
#define LDS_WAIT() asm volatile("s_waitcnt lgkmcnt(0)" ::: "memory")
#define MFMA16(a, b, c) __builtin_amdgcn_mfma_f32_16x16x32_bf16(a, b, c, 0, 0, 0)

using pg8::Unit;
struct EpiProj {
    static constexpr bool PERM = true, AFTER_DRAIN = false;
    bf16_t* O; int ldc;
    __device__ __forceinline__ void operator()(const f32x4 (&acc)[2][2][4][2], const Unit& u, int wr, int wc, int fr, int fq) const {
        const int row0 = u.pm * 256 + wr * 64 + fr, col0 = u.pn * 256 + wc * 32 + 8 * fq;
#pragma unroll
        for (int ai = 0; ai < 2; ++ai)
#pragma unroll
            for (int m = 0; m < 4; ++m) { bf16_t* rowp = O + (size_t)(row0 + ai * 128 + m * 16) * ldc + col0;
#pragma unroll
                for (int bj = 0; bj < 2; ++bj) { const f32x4 v0 = acc[ai][bj][m][0], v1 = acc[ai][bj][m][1];
                    u32x4 w; w.x = pk2x<0>(v0[0], v0[1]); w.y = pk2x<0>(v0[2], v0[3]); w.z = pk2x<0>(v1[0], v1[1]); w.w = pk2x<0>(v1[2], v1[3]);
                    *(u32x4*)(rowp + bj * 128) = w; } }
    }
};
struct EpiMergeA {
    static constexpr bool PERM = true, AFTER_DRAIN = false;
    float* mA; const bf16_t* proj;
    __device__ __forceinline__ void operator()(const f32x4 (&acc)[2][2][4][2], const Unit& u, int wr, int wc, int fr, int fq) const {
        const int row0 = u.pm * 256 + wr * 64 + fr, col0 = u.pn * 256 + wc * 32 + 8 * fq;
#pragma unroll
        for (int ai = 0; ai < 2; ++ai)
#pragma unroll
            for (int m = 0; m < 4; ++m) { const size_t row = (size_t)(row0 + ai * 128 + m * 16);
#pragma unroll
                for (int bj = 0; bj < 2; ++bj) { const int col = col0 + bj * 128;
                    const u32x4 g = *(const u32x4*)(proj + row * LDP + OFF_GA + col);
                    const f32x4 v0 = acc[ai][bj][m][0], v1 = acc[ai][bj][m][1];
                    f32x4 o0, o1;
                    o0[0] = sigmoidf_(bflo(g.x)) * v0[0]; o0[1] = sigmoidf_(bfhi(g.x)) * v0[1]; o0[2] = sigmoidf_(bflo(g.y)) * v0[2]; o0[3] = sigmoidf_(bfhi(g.y)) * v0[3];
                    o1[0] = sigmoidf_(bflo(g.z)) * v1[0]; o1[1] = sigmoidf_(bfhi(g.z)) * v1[1]; o1[2] = sigmoidf_(bflo(g.w)) * v1[2]; o1[3] = sigmoidf_(bfhi(g.w)) * v1[3];
                    float* op = mA + row * DM + col; *(f32x4*)op = o0; *(f32x4*)(op + 4) = o1; } }
    }
};
struct EpiMergeB {
    static constexpr bool PERM = true, AFTER_DRAIN = false;
    const float* mA; bf16_t* mg; const bf16_t* proj;
    __device__ __forceinline__ void operator()(const f32x4 (&acc)[2][2][4][2], const Unit& u, int wr, int wc, int fr, int fq) const {
        const int row0 = u.pm * 256 + wr * 64 + fr, col0 = u.pn * 256 + wc * 32 + 8 * fq;
#pragma unroll
        for (int ai = 0; ai < 2; ++ai)
#pragma unroll
            for (int m = 0; m < 4; ++m) { const size_t row = (size_t)(row0 + ai * 128 + m * 16);
#pragma unroll
                for (int bj = 0; bj < 2; ++bj) { const int col = col0 + bj * 128;
                    const u32x4 g = *(const u32x4*)(proj + row * LDP + OFF_GB + col);
                    const float* ip = mA + row * DM + col; const f32x4 a0 = *(const f32x4*)ip, a1 = *(const f32x4*)(ip + 4);
                    const f32x4 v0 = acc[ai][bj][m][0], v1 = acc[ai][bj][m][1];
                    f32x4 o0, o1;
                    o0[0] = a0[0] + sigmoidf_(bflo(g.x)) * v0[0]; o0[1] = a0[1] + sigmoidf_(bfhi(g.x)) * v0[1]; o0[2] = a0[2] + sigmoidf_(bflo(g.y)) * v0[2]; o0[3] = a0[3] + sigmoidf_(bfhi(g.y)) * v0[3];
                    o1[0] = a1[0] + sigmoidf_(bflo(g.z)) * v1[0]; o1[1] = a1[1] + sigmoidf_(bfhi(g.z)) * v1[1]; o1[2] = a1[2] + sigmoidf_(bflo(g.w)) * v1[2]; o1[3] = a1[3] + sigmoidf_(bfhi(g.w)) * v1[3];
                    u32x4 w; w.x = pk2x<4>(o0[0], o0[1]); w.y = pk2x<4>(o0[2], o0[3]); w.z = pk2x<4>(o1[0], o1[1]); w.w = pk2x<4>(o1[2], o1[3]);
                    *(u32x4*)(mg + row * DM + col) = w; } }
    }
};
struct EpiResid {
    static constexpr bool PERM = false, AFTER_DRAIN = false;
    const float* base; float* of; bf16_t* ob; float* rowsq;
    __device__ __forceinline__ void operator()(const f32x4 (&acc)[2][2][4][2], const Unit& u, int wr, int wc, int fr, int fq) const {
        const int row0 = u.pm * 256 + wr * 64 + fr, col0 = u.pn * 256 + wc * 32 + 4 * fq;
#pragma unroll
        for (int ai = 0; ai < 2; ++ai)
#pragma unroll
            for (int m = 0; m < 4; ++m) { const size_t row = (size_t)(row0 + ai * 128 + m * 16); float ss = 0.f;
#pragma unroll
                for (int bj = 0; bj < 2; ++bj)
#pragma unroll
                    for (int n = 0; n < 2; ++n) { const size_t off = row * DM + col0 + bj * 128 + n * 16;
                        const f32x4 hv = *(const f32x4*)(base + off) + acc[ai][bj][m][n];
                        *(f32x4*)(of + off) = hv;
                        if (ob) { u32x2 w; w.x = pk2x<4>(hv[0], hv[1]); w.y = pk2x<4>(hv[2], hv[3]); *(u32x2*)(ob + off) = w; }
                        ss += (hv[0] * hv[0] + hv[1] * hv[1]) + (hv[2] * hv[2] + hv[3] * hv[3]); }
                ss += __shfl_xor(ss, 16); ss += __shfl_xor(ss, 32);
                if (rowsq && fq == 0) rowsq[row * 32 + u.pn * 4 + wc] = ss; }
    }
};
struct EpiFFN {
    static constexpr bool PERM = true, AFTER_DRAIN = false;
    bf16_t* ff; const float* rowsq;
    __device__ __forceinline__ void operator()(const f32x4 (&acc)[2][2][4][2], const Unit& u, int wr, int wc, int fr, int fq) const {
        const int row0 = u.pm * 256 + wr * 64 + fr, col0 = u.pn * 128 + wc * 32 + 8 * fq;
#pragma unroll
        for (int ai = 0; ai < 2; ++ai)
#pragma unroll
            for (int m = 0; m < 4; ++m) { const size_t row = (size_t)(row0 + ai * 128 + m * 16);
                float sq = 0.f;
#pragma unroll
                for (int q4 = 0; q4 < 8; ++q4) { const f32x4 t = *(const f32x4*)(rowsq + row * 32 + 4 * q4); sq += (t[0] + t[1]) + (t[2] + t[3]); }
                const float rs = rsqrtf(sq * (1.0f / DM) + EPS);
                float o[8];
#pragma unroll
                for (int n = 0; n < 2; ++n)
#pragma unroll
                    for (int j = 0; j < 4; ++j) { const float gt = acc[ai][0][m][n][j] * rs, up = acc[ai][1][m][n][j] * rs; o[n * 4 + j] = siluf_(gt) * up; }
                u32x4 w; w.x = pk2x<4>(o[0], o[1]); w.y = pk2x<4>(o[2], o[3]); w.z = pk2x<4>(o[4], o[5]); w.w = pk2x<4>(o[6], o[7]);
                *(u32x4*)(ff + row * DFF + col0) = w; }
    }
};

__device__ __forceinline__ void transpose_item(const float* __restrict__ W, int N, int K, bf16_t* WT, size_t dst_row0, const float* kscale, LAS float* scr, int k0, int n0, int lane) {
#pragma unroll 8
    for (int i = 0; i < 32; ++i) { const int kk = 2 * i + (lane >> 5); float v = W[(size_t)(k0 + kk) * N + n0 + (lane & 31)]; if (kscale) v *= kscale[k0 + kk]; scr[kk * 33 + (lane & 31)] = v; }
    LDS_WAIT();
    const int c = lane & 7;
#pragma unroll
    for (int j = 0; j < 4; ++j) { const int n = (lane >> 3) + 8 * j; const LAS float* s = scr + (8 * c) * 33 + n;
        u32x4 o; o.x = pk2(s[0 * 33], s[1 * 33]); o.y = pk2(s[2 * 33], s[3 * 33]); o.z = pk2(s[4 * 33], s[5 * 33]); o.w = pk2(s[6 * 33], s[7 * 33]);
        *(u32x4*)(WT + (dst_row0 + n) * (size_t)K + k0 + 8 * c) = o; }
    LDS_WAIT();
}
__device__ __forceinline__ float wave_sum(float v) {
#pragma unroll
    for (int o = 1; o < 64; o <<= 1) v += __shfl_xor(v, o);
    return v;
}
__device__ __forceinline__ void phase0(const Params& p, LAS unsigned char* lds) {
    const int tid = threadIdx.x, lane = tid & 63, wave = __builtin_amdgcn_readfirstlane(tid >> 6);
    const int gw = blockIdx.x * 8 + wave, NGW = gridDim.x * 8;
    LAS float* scr = (LAS float*)(lds + wave * 8448);
    unsigned char* ws = p.ws;
    constexpr int I_IN = 32 * 577, I_SQ = 32 * 64, I_GU = 32 * 176, I_D = 88 * 64;
    constexpr int NITEMS = I_IN + 3 * I_SQ + 2 * I_GU + I_D;
    for (int it = gw; it < NITEMS; it += NGW) {
        int r = it;
        if (r < I_IN) { const int kb = r / 577, nb = r % 577; transpose_item(p.w_in, INW, DM, (bf16_t*)(ws + WS_WIN), (size_t)32 * nb, nullptr, scr, 64 * kb, 32 * nb, lane); continue; } r -= I_IN;
        if (r < I_SQ) { const int kb = r / 64, nb = r % 64; transpose_item(p.w_proj_a, DM, DM, (bf16_t*)(ws + WS_WA), (size_t)32 * nb, nullptr, scr, 64 * kb, 32 * nb, lane); continue; } r -= I_SQ;
        if (r < I_SQ) { const int kb = r / 64, nb = r % 64; transpose_item(p.w_proj_b, DM, DM, (bf16_t*)(ws + WS_WB), (size_t)32 * nb, nullptr, scr, 64 * kb, 32 * nb, lane); continue; } r -= I_SQ;
        if (r < I_SQ) { const int kb = r / 64, nb = r % 64; transpose_item(p.w_out, DM, DM, (bf16_t*)(ws + WS_WO), (size_t)32 * nb, nullptr, scr, 64 * kb, 32 * nb, lane); continue; } r -= I_SQ;
        if (r < I_GU) { const int kb = r / 176, nb = r % 176, n0 = 32 * nb; transpose_item(p.w_gate, DFF, DM, (bf16_t*)(ws + WS_WGU), (size_t)((n0 >> 7) * 256 + (n0 & 127)), p.ln_ffn_g, scr, 64 * kb, n0, lane); continue; } r -= I_GU;
        if (r < I_GU) { const int kb = r / 176, nb = r % 176, n0 = 32 * nb; transpose_item(p.w_up, DFF, DM, (bf16_t*)(ws + WS_WGU), (size_t)((n0 >> 7) * 256 + 128 + (n0 & 127)), p.ln_ffn_g, scr, 64 * kb, n0, lane); continue; } r -= I_GU;
        { const int kb = r / 64, nb = r % 64; transpose_item(p.w_down, DM, DFF, (bf16_t*)(ws + WS_WD), (size_t)32 * nb, nullptr, scr, 64 * kb, 32 * nb, lane); }
    }
    { u32x4* z = (u32x4*)(ws + WS_WIN + (size_t)INW * DM * 2); const size_t nz = (size_t)(LDP - INW) * DM * 2 / 16;
      for (size_t i = (size_t)blockIdx.x * 512 + tid; i < nz; i += (size_t)gridDim.x * 512) z[i] = (u32x4){0u, 0u, 0u, 0u};
    }
    bf16_t* xn = (bf16_t*)(ws + WS_XN);
    for (int m = gw; m < MTOK; m += NGW) {
        const f32x4* xr = (const f32x4*)(p.x + (size_t)m * DM) + lane; const f32x4* gr = (const f32x4*)p.ln_mix_g + lane;
        f32x4 v[8]; float s = 0.f;
#pragma unroll
        for (int j = 0; j < 8; ++j) { v[j] = xr[64 * j]; s += (v[j][0] * v[j][0] + v[j][1] * v[j][1]) + (v[j][2] * v[j][2] + v[j][3] * v[j][3]); }
        const float rs = rsqrtf(wave_sum(s) * (1.0f / DM) + EPS);
        u32x2* o = (u32x2*)(xn + (size_t)m * DM) + lane;
#pragma unroll
        for (int j = 0; j < 8; ++j) { const f32x4 g = gr[64 * j]; u32x2 w; w.x = pk2(v[j][0] * rs * g[0], v[j][1] * rs * g[1]); w.y = pk2(v[j][2] * rs * g[2], v[j][3] * rs * g[3]); o[64 * j] = w; }
    }
}

__device__ __forceinline__ void conv4_rows(const bf16_t* base, int r0, int t0, const float* cw, float (&out)[4][8]) {
    float w[4][8];
#pragma unroll
    for (int i = 0; i < 4; ++i) { const f32x4 a = *(const f32x4*)(cw + i * 6144), b = *(const f32x4*)(cw + i * 6144 + 4);
        w[i][0] = a[0]; w[i][1] = a[1]; w[i][2] = a[2]; w[i][3] = a[3]; w[i][4] = b[0]; w[i][5] = b[1]; w[i][6] = b[2]; w[i][7] = b[3]; }
    float x[7][8];
#pragma unroll
    for (int i = 0; i < 7; ++i) { const int rr = r0 - 3 + i; u32x4 v = (u32x4){0u, 0u, 0u, 0u};
        if (t0 + rr >= 0) v = *(const u32x4*)(base + (ptrdiff_t)rr * LDP);
        x[i][0] = bflo(v.x); x[i][1] = bfhi(v.x); x[i][2] = bflo(v.y); x[i][3] = bfhi(v.y); x[i][4] = bflo(v.z); x[i][5] = bfhi(v.z); x[i][6] = bflo(v.w); x[i][7] = bfhi(v.w); }
#pragma unroll
    for (int r = 0; r < 4; ++r)
#pragma unroll
        for (int j = 0; j < 8; ++j) { const float y = (w[0][j] * x[r][j] + w[1][j] * x[r + 1][j]) + (w[2][j] * x[r + 2][j] + w[3][j] * x[r + 3][j]); out[r][j] = siluf_(y); }
}
constexpr int P2_GRP = 68608;
__device__ __forceinline__ void phase2(const Params& p, LAS unsigned char* lds) {
    const int tid = threadIdx.x, grp = __builtin_amdgcn_readfirstlane(tid >> 8), lane = tid & 63, wvg = __builtin_amdgcn_readfirstlane((tid >> 6) & 3); int gt = tid & 255;
    unsigned char* ws = p.ws;
    const bf16_t* proj = (const bf16_t*)(ws + WS_PROJ);
    LAS unsigned char* gl = lds + grp * P2_GRP;
    LAS float* kn = (LAS float*)gl; LAS float* qn = (LAS float*)(gl + 33792);
    LAS float* Am = (LAS float*)(gl + 33792);
    LAS float* sbeta = (LAS float*)(gl + 67584); LAS float* sgc = sbeta + 64; LAS float* srsw = sbeta + 128;
    for (int item = blockIdx.x; item < 1024; item += gridDim.x) {
        asm volatile("" : "+v"(gt));
        const int unit = item * 2 + grp;
        const int b = unit >> 9, h = (unit >> 5) & 15, n = unit & 31, t0 = n * 64;
        const bf16_t* prow = proj + ((size_t)b * SEQ + t0) * LDP;
        unsigned char* hand = ws + WS_HAND + (size_t)unit * HAND_UNIT;
        bf16_t* w_g = (bf16_t*)hand; bf16_t* qd_g = (bf16_t*)(hand + 16384); bf16_t* kdT_g = (bf16_t*)(hand + 32768); bf16_t* uT_g = (bf16_t*)(hand + 49152); bf16_t* at_g = (bf16_t*)(hand + 65536);
        if (wvg == 0) {
            const float bb = bf2f(prow[(size_t)gt * LDP + OFF_BETA + h]), aa = bf2f(prow[(size_t)gt * LDP + OFF_A + h]);
            const float xs = aa + p.dt_bias[h]; const float sp = xs > 20.f ? xs : __logf(1.0f + __expf(xs));
            float g = -__expf(p.A_log[h]) * sp;
#pragma unroll
            for (int o = 1; o < 64; o <<= 1) { const float t = __shfl_up(g, o); if (lane >= o) g += t; }
            sbeta[gt] = sigmoidf_(bb); sgc[gt] = g;
            if (gt == 63) ((float*)(ws + WS_EGL))[unit] = __expf(g);
        }
        const int r0 = (gt >> 4) * 4, c0 = (gt & 15) * 8;
        float qv[4][8], kv[4][8]; float rnk[4];
        conv4_rows(prow + OFF_Q + h * 128 + c0, r0, t0, p.conv_qkv_w + OFF_Q + h * 128 + c0, qv);
        conv4_rows(prow + OFF_K + h * 128 + c0, r0, t0, p.conv_qkv_w + OFF_K + h * 128 + c0, kv);
#pragma unroll
        for (int r = 0; r < 4; ++r) { float sq = 0.f, sk = 0.f;
#pragma unroll
            for (int j = 0; j < 8; ++j) { sq += qv[r][j] * qv[r][j]; sk += kv[r][j] * kv[r][j]; }
#pragma unroll
            for (int o = 1; o < 16; o <<= 1) { sq += __shfl_xor(sq, o); sk += __shfl_xor(sk, o); }
            const float rq = rsqrtf(sq + EPS) * 0.08838834764831845f; rnk[r] = rsqrtf(sk + EPS);
#pragma unroll
            for (int j = 0; j < 8; ++j) { qv[r][j] *= rq; kv[r][j] *= rnk[r]; } }
        __syncthreads();
        const float gcl = sgc[63];
        float ekl[4];
#pragma unroll
        for (int r = 0; r < 4; ++r) { const int row = r0 + r; const float gc = sgc[row], eg = __expf(gc); ekl[r] = __expf(gcl - gc);
            u32x4 wd;
            *(LAS f32x4*)(qn + row * 132 + c0) = (f32x4){qv[r][0], qv[r][1], qv[r][2], qv[r][3]}; *(LAS f32x4*)(qn + row * 132 + c0 + 4) = (f32x4){qv[r][4], qv[r][5], qv[r][6], qv[r][7]};
            *(LAS f32x4*)(kn + row * 132 + c0) = (f32x4){kv[r][0], kv[r][1], kv[r][2], kv[r][3]}; *(LAS f32x4*)(kn + row * 132 + c0 + 4) = (f32x4){kv[r][4], kv[r][5], kv[r][6], kv[r][7]};
            wd.x = pk2x<1>(qv[r][0] * eg, qv[r][1] * eg); wd.y = pk2x<1>(qv[r][2] * eg, qv[r][3] * eg); wd.z = pk2x<1>(qv[r][4] * eg, qv[r][5] * eg); wd.w = pk2x<1>(qv[r][6] * eg, qv[r][7] * eg);
            *(u32x4*)(qd_g + row * 128 + c0) = wd;
            if ((gt & 15) == 0) srsw[row] = rnk[r] * sbeta[row] * eg; }
#pragma unroll
        for (int j = 0; j < 8; ++j) { u32x2 w; w.x = pk2x<1>(kv[0][j] * ekl[0], kv[1][j] * ekl[1]); w.y = pk2x<1>(kv[2][j] * ekl[2], kv[3][j] * ekl[3]); *(u32x2*)(kdT_g + (c0 + j) * 64 + r0) = w; }
        __syncthreads();
        {
            const int wv = wvg, lr = lane & 15, lq = lane >> 4;
            f32x4 aK[4], aQ[4];
#pragma unroll
            for (int jb = 0; jb < 4; ++jb) { aK[jb] = (f32x4){0.f, 0.f, 0.f, 0.f}; aQ[jb] = (f32x4){0.f, 0.f, 0.f, 0.f}; }
#pragma unroll 2
            for (int kk = 0; kk < 8; ++kk) {
                const f32x4 ka = *(const LAS f32x4*)(kn + (16 * wv + lr) * 132 + 16 * kk + 4 * lq), qa = *(const LAS f32x4*)(qn + (16 * wv + lr) * 132 + 16 * kk + 4 * lq);
#pragma unroll
                for (int jb = 0; jb < 4; ++jb) if (jb <= wv) {
                    const f32x4 kb = *(const LAS f32x4*)(kn + (16 * jb + lr) * 132 + 16 * kk + 4 * lq);
#pragma unroll
                    for (int e = 0; e < 4; ++e) { aK[jb] = __builtin_amdgcn_mfma_f32_16x16x4f32(ka[e], kb[e], aK[jb], 0, 0, 0); aQ[jb] = __builtin_amdgcn_mfma_f32_16x16x4f32(qa[e], kb[e], aQ[jb], 0, 0, 0); }
                }
            }
            __syncthreads();
#pragma unroll
            for (int jb = 0; jb < 4; ++jb) {
                const int j = 16 * jb + lr; const float gcj = sgc[j];
#pragma unroll
                for (int r = 0; r < 4; ++r) { const int i = 16 * wv + 4 * lq + r;
                    const float dec = (i >= j) ? __expf(sgc[i] - gcj) : 0.f;
                    Am[i * 64 + j] = (i > j) ? sbeta[i] * aK[jb][r] * dec : 0.f;
                    at_g[i * 64 + j] = (bf16_t)(pk2x<1>(aQ[jb][r] * dec, 0.f) & 0xffffu); }
            }
        }
        float X[64];
        {
            const bool isv = wvg < 2; const int cc = gt & 127;
            const int col = (isv ? OFF_V : OFF_K) + h * 128 + cc;
            const float* cwp = p.conv_qkv_w + col;
            const float w0 = cwp[0], w1 = cwp[6144], w2 = cwp[2 * 6144], w3 = cwp[3 * 6144];
            const LAS float* scl = isv ? sbeta : srsw;
            const bf16_t* pc = prow + col;
            float x0 = 0.f, x1 = 0.f, x2 = 0.f;
            if (t0 > 0) { x0 = bf2f(pc[-3 * (ptrdiff_t)LDP]); x1 = bf2f(pc[-2 * (ptrdiff_t)LDP]); x2 = bf2f(pc[-(ptrdiff_t)LDP]); }
#pragma unroll
            for (int i = 0; i < 64; ++i) { const float x3 = bf2f(pc[(size_t)i * LDP]); const float y = (w0 * x0 + w1 * x1) + (w2 * x2 + w3 * x3); X[i] = siluf_(y) * scl[i]; x0 = x1; x1 = x2; x2 = x3; }
        }
        __syncthreads();
#pragma unroll
        for (int i = 1; i < 64; ++i) {
            float xa = X[i], xb = 0.f;
#pragma unroll
            for (int j4 = 0; j4 < (i + 3) / 4; ++j4) {
                const f32x4 a = *(const LAS f32x4*)(Am + i * 64 + 4 * j4);
                if (j4 & 1) { xb -= a[0] * X[4 * j4]; xb -= a[1] * X[4 * j4 + 1]; xb -= a[2] * X[4 * j4 + 2]; xb -= a[3] * X[4 * j4 + 3]; }
                else        { xa -= a[0] * X[4 * j4]; xa -= a[1] * X[4 * j4 + 1]; xa -= a[2] * X[4 * j4 + 2]; xa -= a[3] * X[4 * j4 + 3]; }
            }
            X[i] = xa + xb;
        }
        if (wvg < 2) {
#pragma unroll
            for (int i8 = 0; i8 < 8; ++i8) { u32x4 w; w.x = pk2x<1>(X[8 * i8], X[8 * i8 + 1]); w.y = pk2x<1>(X[8 * i8 + 2], X[8 * i8 + 3]); w.z = pk2x<1>(X[8 * i8 + 4], X[8 * i8 + 5]); w.w = pk2x<1>(X[8 * i8 + 6], X[8 * i8 + 7]);
                *(u32x4*)(uT_g + (gt & 127) * 64 + 8 * i8) = w; }
        } else {
#pragma unroll
            for (int i = 0; i < 64; ++i) w_g[i * 128 + (gt & 127)] = (bf16_t)(pk2x<1>(X[i], 0.f) & 0xffffu);
        }
    }
    {
        bf16_t* projw = (bf16_t*)(ws + WS_PROJ);
        for (int item = blockIdx.x; item < 512; item += gridDim.x) {
            const int idx = item * 512 + tid; const int c0 = (idx & 255) * 8, r8 = (idx >> 8) * 8; const int t = r8 & (SEQ - 1);
            float w[3][8];
#pragma unroll
            for (int i = 0; i < 3; ++i) { const f32x4 a = *(const f32x4*)(p.conv_sc_w + i * 2048 + c0), bq = *(const f32x4*)(p.conv_sc_w + i * 2048 + c0 + 4);
                w[i][0] = a[0]; w[i][1] = a[1]; w[i][2] = a[2]; w[i][3] = a[3]; w[i][4] = bq[0]; w[i][5] = bq[1]; w[i][6] = bq[2]; w[i][7] = bq[3]; }
            float p0[8], p1[8];
#pragma unroll
            for (int j = 0; j < 8; ++j) { p0[j] = 0.f; p1[j] = 0.f; }
            if (t > 0) {
                const bf16_t* ra = projw + (size_t)(r8 - 2) * LDP; const bf16_t* rb = projw + (size_t)(r8 - 1) * LDP;
                const u32x4 ca = *(const u32x4*)(ra + OFF_SC + c0), ha = *(const u32x4*)(ra + OFF_SH + c0), cb = *(const u32x4*)(rb + OFF_SC + c0), hb = *(const u32x4*)(rb + OFF_SH + c0);
                p0[0] = bflo(ca.x) * bflo(ha.x); p0[1] = bfhi(ca.x) * bfhi(ha.x); p0[2] = bflo(ca.y) * bflo(ha.y); p0[3] = bfhi(ca.y) * bfhi(ha.y);
                p0[4] = bflo(ca.z) * bflo(ha.z); p0[5] = bfhi(ca.z) * bfhi(ha.z); p0[6] = bflo(ca.w) * bflo(ha.w); p0[7] = bfhi(ca.w) * bfhi(ha.w);
                p1[0] = bflo(cb.x) * bflo(hb.x); p1[1] = bfhi(cb.x) * bfhi(hb.x); p1[2] = bflo(cb.y) * bflo(hb.y); p1[3] = bfhi(cb.y) * bfhi(hb.y);
                p1[4] = bflo(cb.z) * bflo(hb.z); p1[5] = bfhi(cb.z) * bfhi(hb.z); p1[6] = bflo(cb.w) * bflo(hb.w); p1[7] = bfhi(cb.w) * bfhi(hb.w);
            }
#pragma unroll
            for (int i = 0; i < 8; ++i) {
                bf16_t* rp = projw + (size_t)(r8 + i) * LDP;
                const u32x4 cv = *(const u32x4*)(rp + OFF_SC + c0), hv = *(const u32x4*)(rp + OFF_SH + c0), bv = *(const u32x4*)(rp + OFF_SB + c0);
                float p2[8], bb[8], o[8];
                p2[0] = bflo(cv.x) * bflo(hv.x); p2[1] = bfhi(cv.x) * bfhi(hv.x); p2[2] = bflo(cv.y) * bflo(hv.y); p2[3] = bfhi(cv.y) * bfhi(hv.y);
                p2[4] = bflo(cv.z) * bflo(hv.z); p2[5] = bfhi(cv.z) * bfhi(hv.z); p2[6] = bflo(cv.w) * bflo(hv.w); p2[7] = bfhi(cv.w) * bfhi(hv.w);
                bb[0] = bflo(bv.x); bb[1] = bfhi(bv.x); bb[2] = bflo(bv.y); bb[3] = bfhi(bv.y); bb[4] = bflo(bv.z); bb[5] = bfhi(bv.z); bb[6] = bflo(bv.w); bb[7] = bfhi(bv.w);
#pragma unroll
                for (int j = 0; j < 8; ++j) { o[j] = bb[j] * (w[0][j] * p0[j] + w[1][j] * p1[j] + w[2][j] * p2[j]); p0[j] = p1[j]; p1[j] = p2[j]; }
                u32x4 wv; wv.x = pk2x<3>(o[0], o[1]); wv.y = pk2x<3>(o[2], o[3]); wv.z = pk2x<3>(o[4], o[5]); wv.w = pk2x<3>(o[6], o[7]);
                *(u32x4*)(rp + OFF_SB + c0) = wv;
            }
        }
    }
}

__device__ __forceinline__ void phase3(const Params& p, LAS unsigned char* lds) {
    const int tid = threadIdx.x, l = tid & 63, wv = __builtin_amdgcn_readfirstlane(tid >> 6), lr = l & 15, lq = l >> 4, tb = wv & 3, vh = wv >> 2, db = wv;
    unsigned char* ws = p.ws;
    LAS bf16_t* ST = (LAS bf16_t*)lds;
    LAS bf16_t* vT = (LAS bf16_t*)(lds + 34816);
    LAS float* oL = (LAS float*)(lds + 53248);
    LAS float* ngL = (LAS float*)(lds + 87040);
    const int prw = tid >> 3, pcs = (tid & 7) * 16;
    for (int bh = blockIdx.x; bh < 64; bh += gridDim.x) {
        const int b = bh >> 4, h = bh & 15;
        __syncthreads();
        for (int i = tid; i < 34816 / 16; i += 512) ((LAS u32x4*)ST)[i] = (u32x4){0u, 0u, 0u, 0u};
        if (tid < 128) ngL[tid] = p.gdn_norm_g[tid];
        f32x4 accS[8];
#pragma unroll
        for (int v = 0; v < 8; ++v) accS[v] = (f32x4){0.f, 0.f, 0.f, 0.f};
        __syncthreads();
        const unsigned char* hand0 = ws + WS_HAND + (size_t)bh * 32 * HAND_UNIT;
        const float* egl_g = (const float*)(ws + WS_EGL) + bh * 32;
        bf16_t* zbase = (bf16_t*)(ws + WS_PROJ) + ((size_t)b * SEQ + prw) * LDP + OFF_Z + h * 128 + pcs;
        const int o_wq = (16 * tb + lr) * 128 + 8 * lq, o_at = (16 * tb + lr) * 64 + 8 * lq, o_k = (16 * db + lr) * 64 + 8 * lq, o_u = (64 * vh + lr) * 64 + 16 * tb + 4 * lq;
        bf16x8 c_w[4], c_q[4], c_at[2], c_k[2]; u32x2 c_u[4]; u32x4 c_z[2]; float c_e;
#define P3_LOAD_A(nn) do { const bf16_t* hb_ = (const bf16_t*)(hand0 + (size_t)(nn) * HAND_UNIT); \
        _Pragma("unroll") for (int ks = 0; ks < 4; ++ks) { c_w[ks] = *(const bf16x8*)(hb_ + o_wq + 32 * ks); c_q[ks] = *(const bf16x8*)(hb_ + 8192 + o_wq + 32 * ks); } \
        _Pragma("unroll") for (int j = 0; j < 4; ++j) c_u[j] = *(const u32x2*)(hb_ + 24576 + o_u + 1024 * j); } while (0)
#define P3_LOAD_B(nn) do { const bf16_t* hb_ = (const bf16_t*)(hand0 + (size_t)(nn) * HAND_UNIT); \
        _Pragma("unroll") for (int ks = 0; ks < 2; ++ks) { c_at[ks] = *(const bf16x8*)(hb_ + 32768 + o_at + 32 * ks); c_k[ks] = *(const bf16x8*)(hb_ + 16384 + o_k + 32 * ks); } \
        c_e = egl_g[nn]; } while (0)
#define P3_LOAD_Z(nn) do { const bf16_t* zp_ = zbase + (size_t)(nn) * 64 * LDP; c_z[0] = *(const u32x4*)zp_; c_z[1] = *(const u32x4*)(zp_ + 8); } while (0)
        P3_LOAD_A(0); P3_LOAD_B(0); P3_LOAD_Z(0);
        for (int n = 0; n < 32; ++n) {
            const int nn = n < 31 ? n + 1 : 31;
            f32x4 accV[4], accO[4];
#pragma unroll
            for (int j = 0; j < 4; ++j) { accV[j] = (f32x4){0.f, 0.f, 0.f, 0.f}; accO[j] = (f32x4){0.f, 0.f, 0.f, 0.f}; }
#pragma unroll
            for (int j = 0; j < 4; ++j) { const int vb = 4 * vh + j;
#pragma unroll
                for (int ks = 0; ks < 4; ++ks) { const bf16x8 SB = *(const LAS bf16x8*)(ST + (16 * vb + lr) * 136 + 32 * ks + 8 * lq);
                    accV[j] = MFMA16(c_w[ks], SB, accV[j]); accO[j] = MFMA16(c_q[ks], SB, accO[j]); } }
#pragma unroll
            for (int j = 0; j < 4; ++j) { const int vb = 4 * vh + j;
                const float v0 = bflo(c_u[j].x) - accV[j][0], v1 = bfhi(c_u[j].x) - accV[j][1], v2 = bflo(c_u[j].y) - accV[j][2], v3 = bfhi(c_u[j].y) - accV[j][3];
                u32x2 w; w.x = pk2x<2>(v0, v1); w.y = pk2x<2>(v2, v3);
                *(LAS u32x2*)(vT + (16 * vb + lr) * 72 + 16 * tb + 4 * lq) = w; }
            P3_LOAD_A(nn);
            __syncthreads();
#pragma unroll
            for (int j = 0; j < 4; ++j) { const int vb = 4 * vh + j;
#pragma unroll
                for (int ks = 0; ks < 2; ++ks) if (ks == 0 || tb >= 2) { const bf16x8 VB = *(const LAS bf16x8*)(vT + (16 * vb + lr) * 72 + 32 * ks + 8 * lq); accO[j] = MFMA16(c_at[ks], VB, accO[j]); }
#pragma unroll
                for (int r = 0; r < 4; ++r) oL[(16 * tb + 4 * lq + r) * 132 + 16 * vb + lr] = accO[j][r]; }
#pragma unroll
            for (int vb = 0; vb < 8; ++vb) { accS[vb] = accS[vb] * c_e;
#pragma unroll
                for (int ks = 0; ks < 2; ++ks) { const bf16x8 VB = *(const LAS bf16x8*)(vT + (16 * vb + lr) * 72 + 32 * ks + 8 * lq); accS[vb] = MFMA16(c_k[ks], VB, accS[vb]); }
                u32x2 w; w.x = pk2x<2>(accS[vb][0], accS[vb][1]); w.y = pk2x<2>(accS[vb][2], accS[vb][3]);
                *(LAS u32x2*)(ST + (16 * vb + lr) * 136 + 16 * db + 4 * lq) = w; }
            P3_LOAD_B(nn);
            __syncthreads();
            {
                float o[16]; float ss = 0.f;
#pragma unroll
                for (int q4 = 0; q4 < 4; ++q4) { const f32x4 t = *(const LAS f32x4*)(oL + prw * 132 + pcs + 4 * q4); o[4 * q4] = t[0]; o[4 * q4 + 1] = t[1]; o[4 * q4 + 2] = t[2]; o[4 * q4 + 3] = t[3];
                    ss += (t[0] * t[0] + t[1] * t[1]) + (t[2] * t[2] + t[3] * t[3]); }
                ss += __shfl_xor(ss, 1); ss += __shfl_xor(ss, 2); ss += __shfl_xor(ss, 4);
                const float rs = rsqrtf(ss * (1.0f / 128.0f) + EPS);
                float zf[16];
                zf[0] = bflo(c_z[0].x); zf[1] = bfhi(c_z[0].x); zf[2] = bflo(c_z[0].y); zf[3] = bfhi(c_z[0].y); zf[4] = bflo(c_z[0].z); zf[5] = bfhi(c_z[0].z); zf[6] = bflo(c_z[0].w); zf[7] = bfhi(c_z[0].w);
                zf[8] = bflo(c_z[1].x); zf[9] = bfhi(c_z[1].x); zf[10] = bflo(c_z[1].y); zf[11] = bfhi(c_z[1].y); zf[12] = bflo(c_z[1].z); zf[13] = bfhi(c_z[1].z); zf[14] = bflo(c_z[1].w); zf[15] = bfhi(c_z[1].w);
#pragma unroll
                for (int q4 = 0; q4 < 4; ++q4) { const f32x4 g = *(const LAS f32x4*)(ngL + pcs + 4 * q4);
#pragma unroll
                    for (int j = 0; j < 4; ++j) o[4 * q4 + j] = o[4 * q4 + j] * rs * g[j] * siluf_(zf[4 * q4 + j]); }
                u32x4 w0, w1;
                w0.x = pk2x<3>(o[0], o[1]); w0.y = pk2x<3>(o[2], o[3]); w0.z = pk2x<3>(o[4], o[5]); w0.w = pk2x<3>(o[6], o[7]);
                w1.x = pk2x<3>(o[8], o[9]); w1.y = pk2x<3>(o[10], o[11]); w1.z = pk2x<3>(o[12], o[13]); w1.w = pk2x<3>(o[14], o[15]);
                bf16_t* zp = zbase + (size_t)n * 64 * LDP; *(u32x4*)zp = w0; *(u32x4*)(zp + 8) = w1;
            }
            P3_LOAD_Z(nn);
        }
#undef P3_LOAD_A
#undef P3_LOAD_B
#undef P3_LOAD_Z
    }
}

__device__ __forceinline__ void phase8(const Params& p) {
    const int tid = threadIdx.x, lane = tid & 63, wave = __builtin_amdgcn_readfirstlane(tid >> 6);
    const int gw = blockIdx.x * 8 + wave, NGW = gridDim.x * 8;
    for (int m = gw; m < MTOK; m += NGW) {
        f32x4* xr = (f32x4*)(p.out + (size_t)m * DM) + lane; const f32x4* gr = (const f32x4*)p.ln_final_g + lane;
        f32x4 v[8]; float s = 0.f;
#pragma unroll
        for (int j = 0; j < 8; ++j) { v[j] = xr[64 * j]; s += (v[j][0] * v[j][0] + v[j][1] * v[j][1]) + (v[j][2] * v[j][2] + v[j][3] * v[j][3]); }
        const float rs = rsqrtf(wave_sum(s) * (1.0f / DM) + EPS);
#pragma unroll
        for (int j = 0; j < 8; ++j) { const f32x4 g = gr[64 * j]; xr[64 * j] = v[j] * rs * g; }
    }
}

__global__ void __launch_bounds__(512, 2) hybrid_fwd(Params p) {
    extern __shared__ __attribute__((aligned(16))) unsigned char smem[];
    LAS unsigned char* lds = (LAS unsigned char*)smem;
    cg::grid_group grid = cg::this_grid();
    unsigned char* ws = p.ws;
    const int lo = p.ph_lo, hi = p.ph_hi, G = gridDim.x, c = blockIdx.x;
#define IN(k) (lo <= (k) && (k) < hi)
#define SEAM(k) do { if (IN(k) && IN((k) + 1)) { __threadfence(); grid.sync(); __threadfence(); } } while (0)
    if (IN(0)) phase0(p, lds);
    SEAM(0);
    if (IN(1)) { pg8::Gemm g{(const bf16_t*)(ws + WS_XN), (const bf16_t*)(ws + WS_WIN), MTOK, LDP, DM, DM}; pg8::StaticOrder S; S.init(MTOK, LDP, G, c);
        EpiProj E{(bf16_t*)(ws + WS_PROJ), LDP}; pg8::gemm_phase<EpiProj, pg8::StaticOrder>(lds, g, S, E, nullptr); }
    SEAM(1);
    if (IN(2)) phase2(p, lds);
    SEAM(2);
    if (IN(3)) phase3(p, lds);
    SEAM(3);
    if (IN(4)) {
        { pg8::Gemm g{(const bf16_t*)(ws + WS_PROJ) + OFF_Z, (const bf16_t*)(ws + WS_WA), MTOK, DM, DM, LDP}; pg8::StaticOrder S; S.init(MTOK, DM, G, c);
          EpiMergeA E{(float*)(ws + WS_MA), (const bf16_t*)(ws + WS_PROJ)}; pg8::gemm_phase<EpiMergeA, pg8::StaticOrder>(lds, g, S, E, nullptr); }
        __syncthreads();
        { pg8::Gemm g{(const bf16_t*)(ws + WS_PROJ) + OFF_SB, (const bf16_t*)(ws + WS_WB), MTOK, DM, DM, LDP}; pg8::StaticOrder S; S.init(MTOK, DM, G, c);
          EpiMergeB E{(const float*)(ws + WS_MA), (bf16_t*)(ws + WS_MB), (const bf16_t*)(ws + WS_PROJ)}; pg8::gemm_phase<EpiMergeB, pg8::StaticOrder>(lds, g, S, E, nullptr); }
    }
    SEAM(4);
    if (IN(5)) { pg8::Gemm g{(const bf16_t*)(ws + WS_MB), (const bf16_t*)(ws + WS_WO), MTOK, DM, DM, DM}; pg8::StaticOrder S; S.init(MTOK, DM, G, c);
        EpiResid E{p.x, (float*)(ws + WS_H1F), (bf16_t*)(ws + WS_H1B), (float*)(ws + WS_RSQ1)}; pg8::gemm_phase<EpiResid, pg8::StaticOrder>(lds, g, S, E, nullptr); }
    SEAM(5);
    if (IN(6)) { pg8::Gemm g{(const bf16_t*)(ws + WS_H1B), (const bf16_t*)(ws + WS_WGU), MTOK, 2 * DFF, DM, DM}; pg8::StaticOrder S; S.init(MTOK, 2 * DFF, G, c);
        EpiFFN E{(bf16_t*)(ws + WS_FF), (const float*)(ws + WS_RSQ1)}; pg8::gemm_phase<EpiFFN, pg8::StaticOrder>(lds, g, S, E, nullptr); }
    SEAM(6);
    if (IN(7)) { pg8::Gemm g{(const bf16_t*)(ws + WS_FF), (const bf16_t*)(ws + WS_WD), MTOK, DM, DFF, DFF}; pg8::StaticOrder S; S.init(MTOK, DM, G, c);
        EpiResid E{(const float*)(ws + WS_H1F), p.out, nullptr, nullptr}; pg8::gemm_phase<EpiResid, pg8::StaticOrder>(lds, g, S, E, nullptr); }
    SEAM(7);
    if (IN(8)) phase8(p);
#undef IN
#undef SEAM
}

extern "C" void kernel_launch(void* const* d_in, const int* in_sizes, int n_in, void* d_out, int out_size, void* d_ws, size_t ws_size, hipStream_t stream) {
    constexpr int LDS_BYTES = 147456;
    static int grid = 0;
    if (grid == 0) {
        if (n_in != 16 || out_size != MTOK * DM || ws_size < WS_END) { fprintf(stderr, "kernel_launch: unexpected shapes (n_in %d out %d ws %zu need %zu)\n", n_in, out_size, ws_size, (size_t)WS_END); grid = -1; return; }
        int dev = 0, cus = 0, per_cu = 0;
        hipGetDevice(&dev); hipDeviceGetAttribute(&cus, hipDeviceAttributeMultiprocessorCount, dev);
        if (hipFuncSetAttribute((const void*)hybrid_fwd, hipFuncAttributeMaxDynamicSharedMemorySize, LDS_BYTES) != hipSuccess) { fprintf(stderr, "kernel_launch: hipFuncSetAttribute failed\n"); grid = -1; return; }
        if (hipOccupancyMaxActiveBlocksPerMultiprocessor(&per_cu, (const void*)hybrid_fwd, 512, LDS_BYTES) != hipSuccess || per_cu < 1) { fprintf(stderr, "kernel_launch: occupancy query says %d blocks per CU\n", per_cu); per_cu = 1; }
        (void)hipGetLastError();
        grid = cus * 1;
        fprintf(stderr, "kernel_launch: cus %d per_cu %d grid %d ws %zu need %zu\n", cus, per_cu, grid, ws_size, (size_t)WS_END);
    }
    if (grid < 0) return;
    Params p{};
    p.x = (const float*)d_in[0]; p.ln_mix_g = (const float*)d_in[1]; p.w_in = (const float*)d_in[2]; p.conv_qkv_w = (const float*)d_in[3]; p.A_log = (const float*)d_in[4]; p.dt_bias = (const float*)d_in[5];
    p.gdn_norm_g = (const float*)d_in[6]; p.w_proj_a = (const float*)d_in[7]; p.conv_sc_w = (const float*)d_in[8]; p.w_proj_b = (const float*)d_in[9]; p.w_out = (const float*)d_in[10]; p.ln_ffn_g = (const float*)d_in[11];
    p.w_gate = (const float*)d_in[12]; p.w_up = (const float*)d_in[13]; p.w_down = (const float*)d_in[14]; p.ln_final_g = (const float*)d_in[15];
    p.out = (float*)d_out; p.ws = (unsigned char*)d_ws;
#if N_LAUNCHES == 1
    p.ph_lo = 0; p.ph_hi = NPHASE;
    void* args[] = {&p};
    hipError_t e = hipLaunchCooperativeKernel((const void*)hybrid_fwd, dim3(grid), dim3(512), args, LDS_BYTES, stream);
    if (e != hipSuccess) fprintf(stderr, "kernel_launch: cooperative launch failed: %s (grid %d)\n", hipGetErrorString(e), grid);
#else
    for (int k = 0; k < NPHASE; ++k) { p.ph_lo = k; p.ph_hi = k + 1; hipLaunchKernelGGL(hybrid_fwd, dim3(grid), dim3(512), LDS_BYTES, stream, p); }
#endif
}
```

```cpp
#include <hip/hip_runtime.h>
#include <hip/hip_cooperative_groups.h>
#include <cstdio>
namespace cg = cooperative_groups;
#define N_LAUNCHES 1
#define TRUNC_MASK 0
#define DUP_MASK 0
namespace pg8 {
#define PG8_LAS __attribute__((address_space(3)))
typedef unsigned short bf16_t;
typedef short bf16x8 __attribute__((ext_vector_type(8)));
typedef float f32x4 __attribute__((ext_vector_type(4)));
typedef unsigned u32x4 __attribute__((ext_vector_type(4)));
constexpr int BM = 256, BK = 64, HALF = 128, HTB = HALF * BK * 2  , STAGE_BYTES = 8 * HTB, NXCD = 8, WGM = 8;

__host__ __device__ __forceinline__ int lds_byte(int r, int c) { const int st = (r >> 4) * 2 + (c >> 5), rr = r & 15, cc = c & 31, ob = rr * 64 + cc * 2; return st * 1024 + (ob ^ (((ob >> 9) & 1) << 5)); }
__host__ __device__ __forceinline__ void stage_rc(int b, int& R, int& C) { const int st = b / 1024, sb = b % 1024, swz = sb ^ (((sb >> 9) & 1) << 5); R = (st >> 1) * 16 + swz / 64; C = (st & 1) * 32 + (swz % 64) / 2; }
__host__ __device__ __forceinline__ int perm32(int rho) { const int n = rho >> 4, i = rho & 15; return 8 * (i >> 2) + 4 * n + (i & 3); }

struct Unit { int pm, pn; };
struct Gemm { const bf16_t* A; const bf16_t* Bt; int M, N, K, lda; };

struct StaticOrder {
    int nM, nN, nwg, G, c;
    __host__ __device__ void init(int M, int N, int G_, int c_) { nM = M / BM; nN = N / BM; nwg = nM * nN; G = G_; c = c_; }
    __host__ __device__ bool next(int i, Unit& u) const {
        const long L = (long)i * G + c; if (L >= nwg) return false;
        int wgid = (int)L; { const int q = nwg / NXCD, r = nwg % NXCD, xcd = wgid % NXCD, off = wgid / NXCD; wgid = (xcd < r ? xcd * (q + 1) : r * (q + 1) + (xcd - r) * q) + off; }
        const int nig = WGM * nN, gid = wgid / nig, fm = gid * WGM, gsz = (nM - fm) < WGM ? (nM - fm) : WGM;
        u.pm = fm + ((wgid % nig) % gsz); u.pn = (wgid % nig) / gsz; return true;
    }
    __device__ __forceinline__ void a_ready(const Unit&) const {}
    __device__ __forceinline__ void done(const Unit&) const {}
};
__device__ __forceinline__ unsigned cvt_pk_bf16(float lo, float hi) { unsigned r; asm volatile("v_cvt_pk_bf16_f32 %0, %1, %2" : "=v"(r) : "v"(lo), "v"(hi)); return r; }
template <class Epi, class Sched, bool STAMP = false>
__device__ __forceinline__ void gemm_phase(PG8_LAS unsigned char* lds, const Gemm g, const Sched& S, const Epi& E, unsigned long long* stamps) {
    const int tid = threadIdx.x, wid = __builtin_amdgcn_readfirstlane(tid >> 6), lane = tid & 63, wr = wid >> 2, wc = wid & 3, fr = lane & 15, fq = lane >> 4;
    const int K = g.K, nt = K / BK;
    int ts_lo = 0, ts_hi = 0, nts = 0; const unsigned long long rt_entry = STAMP ? (unsigned long long)wall_clock64() : 0ull;
#define PG8_STAMP() do { if (STAMP && wid == 0 && nts < 64) { const unsigned long long _c = (unsigned long long)clock64(); \
        ts_lo = (lane == nts) ? (int)(unsigned)_c : ts_lo; ts_hi = (lane == nts) ? (int)(unsigned)(_c >> 32) : ts_hi; ++nts; } } while (0)
    PG8_STAMP();
    unsigned voffA[2], voffB[2];
#pragma unroll
    for (int i = 0; i < 2; ++i) { int R, C; stage_rc(tid * 16 + i * 8192, R, C); const int Rb = Epi::PERM ? ((R & ~31) + perm32(R & 31)) : R;
        voffA[i] = (unsigned)(R * g.lda + C) * 2u; voffB[i] = (unsigned)(Rb * K + C) * 2u; }
    const size_t kstep = (size_t)(BK * 2);
    const size_t hstepA = (size_t)HALF * g.lda * 2, hstepB = (size_t)HALF * K * 2;
    const size_t tstepA = 2 * hstepA, tstepB = 2 * hstepB;
    const unsigned ldsw = (unsigned)wid * 1024u;
    const int aoff = lds_byte(wr * 64 + fr, fq * 8), boff = lds_byte(wc * 32 + fr, fq * 8);
#define PG8_SA(b, h) (((b) * 2 + (h)) * HTB)
#define PG8_SB(b, h) ((4 + (b) * 2 + (h)) * HTB)
#define PG8_STAGE(bufoff, gbase, voff) do { _Pragma("unroll") for (int _i = 0; _i < 2; ++_i) \
        __builtin_amdgcn_global_load_lds((const unsigned*)((const char*)(gbase) + (voff)[_i]), (PG8_LAS unsigned*)(lds + (bufoff) + ldsw + _i * 8192), 16, 0, 0); } while (0)
#define PG8_LDA(dst, b, h) do { _Pragma("unroll") for (int m = 0; m < 4; ++m) _Pragma("unroll") for (int k = 0; k < 2; ++k) dst[m][k] = *(const PG8_LAS bf16x8*)(lds + PG8_SA(b, h) + aoff + m * 2048 + k * 1024); } while (0)
#define PG8_LDB(dst, b, h) do { _Pragma("unroll") for (int n = 0; n < 2; ++n) _Pragma("unroll") for (int k = 0; k < 2; ++k) dst[n][k] = *(const PG8_LAS bf16x8*)(lds + PG8_SB(b, h) + boff + n * 2048 + k * 1024); } while (0)
#define PG8_MMA(ai, bj, At, Bt) do { __builtin_amdgcn_s_setprio(1); _Pragma("unroll") for (int m = 0; m < 4; ++m) _Pragma("unroll") for (int n = 0; n < 2; ++n) _Pragma("unroll") for (int k = 0; k < 2; ++k) \
        acc[ai][bj][m][n] = __builtin_amdgcn_mfma_f32_16x16x32_bf16(Bt[n][k], At[m][k], acc[ai][bj][m][n], 0, 0, 0); __builtin_amdgcn_s_setprio(0); } while (0)
#define PG8_WAIT_V(n) asm volatile("s_waitcnt vmcnt(" #n ")" ::: "memory")
#define PG8_WAIT_L(n) asm volatile("s_waitcnt lgkmcnt(" #n ")" ::: "memory")
#define PG8_BAR __builtin_amdgcn_s_barrier()
#define PG8_SCHED __builtin_amdgcn_sched_barrier(0)
    Unit cur, nxt; int ui = 0;
    if (!S.next(0, cur)) return;
    f32x4 acc[2][2][4][2];
#pragma unroll
    for (int a = 0; a < 2; ++a)
#pragma unroll
        for (int b = 0; b < 2; ++b)
#pragma unroll
            for (int m = 0; m < 4; ++m)
#pragma unroll
                for (int n = 0; n < 2; ++n) acc[a][b][m][n] = (f32x4){0.f, 0.f, 0.f, 0.f};
    bf16x8 At[4][2], B0[2][2], B1[2][2];
    const char* cA = (const char*)g.A + (size_t)cur.pm * tstepA; const char* cB = (const char*)g.Bt + (size_t)cur.pn * tstepB;
    S.a_ready(cur);
    PG8_STAGE(PG8_SB(0, 0), cB, voffB); PG8_STAGE(PG8_SA(0, 0), cA, voffA); PG8_STAGE(PG8_SB(0, 1), cB + hstepB, voffB); PG8_STAGE(PG8_SA(0, 1), cA + hstepA, voffA);
    if (wr == 1) PG8_BAR;
    PG8_WAIT_V(4); PG8_BAR;
    PG8_STAGE(PG8_SB(1, 0), cB + kstep, voffB); PG8_STAGE(PG8_SA(1, 0), cA + kstep, voffA); PG8_STAGE(PG8_SB(1, 1), cB + hstepB + kstep, voffB);
    PG8_WAIT_V(6); PG8_BAR;
    PG8_STAMP();
    for (;;) {
        const bool has_next = S.next(ui + 1, nxt);
        const char* nA = has_next ? (const char*)g.A + (size_t)nxt.pm * tstepA : cA; const char* nB = has_next ? (const char*)g.Bt + (size_t)nxt.pn * tstepB : cB;
        for (int t = 0; t < nt; t += 2) {
            const bool last = (t == nt - 2);
            const char* a1 = cA + (size_t)(t + 1) * kstep;
            const char* a2 = last ? nA : cA + (size_t)(t + 2) * kstep; const char* b2 = last ? nB : cB + (size_t)(t + 2) * kstep;
            const char* a3 = a2 + kstep; const char* b3 = b2 + kstep;
            if (last && has_next) S.a_ready(nxt);
            PG8_LDB(B0, 0, 0); PG8_SCHED; PG8_LDA(At, 0, 0); PG8_STAGE(PG8_SA(1, 1), a1 + hstepA, voffA);
            PG8_WAIT_L(8); PG8_BAR; PG8_WAIT_L(0); PG8_MMA(0, 0, At, B0); PG8_BAR; PG8_SCHED;
            PG8_LDB(B1, 0, 1); PG8_STAGE(PG8_SB(0, 0), b2, voffB);
            PG8_BAR; PG8_WAIT_L(0); PG8_MMA(0, 1, At, B1); PG8_BAR;
            PG8_LDA(At, 0, 1); PG8_STAGE(PG8_SA(0, 0), a2, voffA);
            PG8_BAR; PG8_WAIT_L(0); PG8_MMA(1, 0, At, B0); PG8_BAR; PG8_SCHED;
            PG8_STAGE(PG8_SB(0, 1), b2 + hstepB, voffB);
            PG8_WAIT_V(6); PG8_BAR; PG8_MMA(1, 1, At, B1); PG8_BAR;
            PG8_LDB(B0, 1, 0); PG8_SCHED; PG8_LDA(At, 1, 0); PG8_STAGE(PG8_SA(0, 1), a2 + hstepA, voffA);
            PG8_WAIT_L(8); PG8_BAR; PG8_WAIT_L(0); PG8_MMA(0, 0, At, B0); PG8_BAR; PG8_SCHED;
            PG8_LDB(B1, 1, 1); PG8_STAGE(PG8_SB(1, 0), b3, voffB);
            PG8_BAR; PG8_WAIT_L(0); PG8_MMA(0, 1, At, B1); PG8_BAR;
            PG8_LDA(At, 1, 1); PG8_STAGE(PG8_SA(1, 0), a3, voffA);
            PG8_BAR; PG8_WAIT_L(0); PG8_MMA(1, 0, At, B0); PG8_BAR; PG8_SCHED;
            PG8_STAGE(PG8_SB(1, 1), b3 + hstepB, voffB);
            PG8_WAIT_V(6); PG8_BAR; PG8_MMA(1, 1, At, B1); PG8_BAR;
        }
        PG8_STAMP();
        if constexpr (!Epi::AFTER_DRAIN) { E(acc, cur, wr, wc, fr, fq); S.done(cur); }
        PG8_STAMP();
        if (!has_next) break;
#pragma unroll
        for (int a = 0; a < 2; ++a)
#pragma unroll
            for (int b = 0; b < 2; ++b)
#pragma unroll
                for (int m = 0; m < 4; ++m)
#pragma unroll
                    for (int n = 0; n < 2; ++n) acc[a][b][m][n] = (f32x4){0.f, 0.f, 0.f, 0.f};
        cur = nxt; cA = nA; cB = nB; ++ui;
    }
    PG8_WAIT_V(0);
    if (wr == 0) PG8_BAR;
    PG8_BAR;
    if constexpr (Epi::AFTER_DRAIN) { E.fused(acc, cur, wr, wc, fr, fq, lds, wid, lane); S.done(cur); }
    PG8_STAMP();
    if (STAMP && wid == 0) { stamps[lane] = lane < nts ? (((unsigned long long)(unsigned)ts_hi << 32) | (unsigned)ts_lo) : 0ull;
        if (lane == 62) stamps[62] = rt_entry; if (lane == 63) stamps[63] = (unsigned long long)wall_clock64(); }
#undef PG8_STAMP
#undef PG8_SA
#undef PG8_SB
#undef PG8_STAGE
#undef PG8_LDA
#undef PG8_LDB
#undef PG8_MMA
#undef PG8_WAIT_V
#undef PG8_WAIT_L
#undef PG8_BAR
#undef PG8_SCHED
}
}

#define LAS __attribute__((address_space(3)))
typedef unsigned short bf16_t;
typedef short bf16x8 __attribute__((ext_vector_type(8)));
typedef float f32x4 __attribute__((ext_vector_type(4)));
typedef unsigned u32x4 __attribute__((ext_vector_type(4)));
typedef unsigned u32x2 __attribute__((ext_vector_type(2)));

constexpr int MTOK = 8192, DM = 2048, SEQ = 2048, NH = 16, DFF = 5632, INW = 18464, LDP = 18432;
constexpr int OFF_Q = 0, OFF_K = 2048, OFF_V = 4096, OFF_Z = 6144, OFF_SB = 8192, OFF_SC = 10240, OFF_SH = 12288, OFF_GA = 14336, OFF_GB = 16384;
constexpr float EPS = 1e-6f;
constexpr int NPHASE = 9;
#ifndef N_LAUNCHES
#define N_LAUNCHES 1
#endif

constexpr size_t HAND_UNIT = 73728;
constexpr size_t WS_A0 = 0;
constexpr size_t WS_WIN = WS_A0, WS_XN = WS_A0 + (size_t)LDP * DM * 2;
constexpr size_t WS_HAND = WS_A0, WS_MA = WS_A0, WS_MB = WS_A0 + (size_t)MTOK * DM * 4;
constexpr size_t A0_BYTES = 2048 * HAND_UNIT;
constexpr size_t WS_PROJ = WS_A0 + A0_BYTES;
constexpr size_t WS_H1F = WS_PROJ, WS_H1B = WS_PROJ + (size_t)MTOK * DM * 4, WS_FF = WS_H1B + (size_t)MTOK * DM * 2;
constexpr size_t WS_WA = WS_PROJ + (size_t)MTOK * LDP * 2;
constexpr size_t WS_WB = WS_WA + (size_t)DM * DM * 2, WS_WO = WS_WB + (size_t)DM * DM * 2, WS_WGU = WS_WO + (size_t)DM * DM * 2;
constexpr size_t WS_WD = WS_WGU + (size_t)2 * DFF * DM * 2;
constexpr size_t WS_EGL = WS_WD + (size_t)DM * DFF * 2;
constexpr size_t WS_RSQ1 = WS_EGL + 2048 * 4, WS_WBA = WS_RSQ1 + (size_t)MTOK * 32 * 4, WS_BA = WS_WBA + (size_t)32 * DM * 2, WS_END = WS_BA + (size_t)MTOK * 32 * 4;
static_assert(WS_XN + (size_t)MTOK * DM * 2 <= A0_BYTES && WS_MB + (size_t)MTOK * DM * 2 <= A0_BYTES, "A0 overlays");
static_assert(WS_FF + (size_t)MTOK * DFF * 2 <= WS_WA, "proj overlays");

struct Params {
    const float *x, *ln_mix_g, *w_in, *conv_qkv_w, *A_log, *dt_bias, *gdn_norm_g, *w_proj_a, *conv_sc_w, *w_proj_b, *w_out, *ln_ffn_g, *w_gate, *w_up, *w_down, *ln_final_g;
    float* out; unsigned char* ws; int ph_lo, ph_hi;
};

__device__ __forceinline__ float bf2f(bf16_t u) { return __uint_as_float((unsigned)u << 16); }
__device__ __forceinline__ float bflo(unsigned w) { return __uint_as_float(w << 16); }
__device__ __forceinline__ float bfhi(unsigned w) { return __uint_as_float(w & 0xffff0000u); }
typedef float f32x2_t __attribute__((ext_vector_type(2)));
typedef __bf16 bf16x2_t __attribute__((ext_vector_type(2)));
__device__ __forceinline__ unsigned pk2(float lo, float hi) { const f32x2_t v = {lo, hi}; const bf16x2_t b = __builtin_convertvector(v, bf16x2_t); return __builtin_bit_cast(unsigned, b); }
#ifndef TRUNC_MASK
#define TRUNC_MASK 0
#endif
template <int K> __device__ __forceinline__ unsigned pk2x(float lo, float hi) {
    if ((TRUNC_MASK >> K) & 1) return (__float_as_uint(hi) & 0xffff0000u) | (__float_as_uint(lo) >> 16);
    return pk2(lo, hi);
}
__device__ __forceinline__ float sigmoidf_(float x) { return 1.0f / (1.0f + __expf(-x)); }
__device__ __forceinline__ float siluf_(float x) { return x / (1.0f + __expf(-x)); }
#define LDS_WAIT() asm volatile("s_waitcnt lgkmcnt(0)" ::: "memory")
#define LDS_BARRIER() do { asm volatile("s_waitcnt lgkmcnt(0)" ::: "memory"); __builtin_amdgcn_s_barrier(); asm volatile("" ::: "memory"); } while (0)
#define MFMA16(a, b, c) __builtin_amdgcn_mfma_f32_16x16x32_bf16(a, b, c, 0, 0, 0)

using pg8::Unit;
struct EpiProj {
    static constexpr bool PERM = true, AFTER_DRAIN = false;
    bf16_t* O; int ldc;
    __device__ __forceinline__ void operator()(const f32x4 (&acc)[2][2][4][2], const Unit& u, int wr, int wc, int fr, int fq) const {
        const int row0 = u.pm * 256 + wr * 64 + fr, col0 = u.pn * 256 + wc * 32 + 8 * fq;
#pragma unroll
        for (int ai = 0; ai < 2; ++ai)
#pragma unroll
            for (int m = 0; m < 4; ++m) { bf16_t* rowp = O + (size_t)(row0 + ai * 128 + m * 16) * ldc + col0;
#pragma unroll
                for (int bj = 0; bj < 2; ++bj) { const f32x4 v0 = acc[ai][bj][m][0], v1 = acc[ai][bj][m][1];
                    u32x4 w; w.x = pk2x<0>(v0[0], v0[1]); w.y = pk2x<0>(v0[2], v0[3]); w.z = pk2x<0>(v1[0], v1[1]); w.w = pk2x<0>(v1[2], v1[3]);
                    *(u32x4*)(rowp + bj * 128) = w; } }
    }
};
struct EpiMergeA {
    static constexpr bool PERM = true, AFTER_DRAIN = false;
    float* mA; const bf16_t* proj;
    __device__ __forceinline__ void operator()(const f32x4 (&acc)[2][2][4][2], const Unit& u, int wr, int wc, int fr, int fq) const {
        const int row0 = u.pm * 256 + wr * 64 + fr, col0 = u.pn * 256 + wc * 32 + 8 * fq;
#pragma unroll
        for (int ai = 0; ai < 2; ++ai)
#pragma unroll
            for (int m = 0; m < 4; ++m) { const size_t row = (size_t)(row0 + ai * 128 + m * 16);
#pragma unroll
                for (int bj = 0; bj < 2; ++bj) { const int col = col0 + bj * 128;
                    const u32x4 g = *(const u32x4*)(proj + row * LDP + OFF_GA + col);
                    const f32x4 v0 = acc[ai][bj][m][0], v1 = acc[ai][bj][m][1];
                    f32x4 o0, o1;
                    o0[0] = sigmoidf_(bflo(g.x)) * v0[0]; o0[1] = sigmoidf_(bfhi(g.x)) * v0[1]; o0[2] = sigmoidf_(bflo(g.y)) * v0[2]; o0[3] = sigmoidf_(bfhi(g.y)) * v0[3];
                    o1[0] = sigmoidf_(bflo(g.z)) * v1[0]; o1[1] = sigmoidf_(bfhi(g.z)) * v1[1]; o1[2] = sigmoidf_(bflo(g.w)) * v1[2]; o1[3] = sigmoidf_(bfhi(g.w)) * v1[3];
                    float* op = mA + row * DM + col; *(f32x4*)op = o0; *(f32x4*)(op + 4) = o1; } }
    }
};
struct EpiMergeB {
    static constexpr bool PERM = true, AFTER_DRAIN = false;
    const float* mA; bf16_t* mg; const bf16_t* proj;
    __device__ __forceinline__ void operator()(const f32x4 (&acc)[2][2][4][2], const Unit& u, int wr, int wc, int fr, int fq) const {
        const int row0 = u.pm * 256 + wr * 64 + fr, col0 = u.pn * 256 + wc * 32 + 8 * fq;
#pragma unroll
        for (int ai = 0; ai < 2; ++ai)
#pragma unroll
            for (int m = 0; m < 4; ++m) { const size_t row = (size_t)(row0 + ai * 128 + m * 16);
#pragma unroll
                for (int bj = 0; bj < 2; ++bj) { const int col = col0 + bj * 128;
                    const u32x4 g = *(const u32x4*)(proj + row * LDP + OFF_GB + col);
                    const float* ip = mA + row * DM + col; const f32x4 a0 = *(const f32x4*)ip, a1 = *(const f32x4*)(ip + 4);
                    const f32x4 v0 = acc[ai][bj][m][0], v1 = acc[ai][bj][m][1];
                    f32x4 o0, o1;
                    o0[0] = a0[0] + sigmoidf_(bflo(g.x)) * v0[0]; o0[1] = a0[1] + sigmoidf_(bfhi(g.x)) * v0[1]; o0[2] = a0[2] + sigmoidf_(bflo(g.y)) * v0[2]; o0[3] = a0[3] + sigmoidf_(bfhi(g.y)) * v0[3];
                    o1[0] = a1[0] + sigmoidf_(bflo(g.z)) * v1[0]; o1[1] = a1[1] + sigmoidf_(bfhi(g.z)) * v1[1]; o1[2] = a1[2] + sigmoidf_(bflo(g.w)) * v1[2]; o1[3] = a1[3] + sigmoidf_(bfhi(g.w)) * v1[3];
                    u32x4 w; w.x = pk2x<4>(o0[0], o0[1]); w.y = pk2x<4>(o0[2], o0[3]); w.z = pk2x<4>(o1[0], o1[1]); w.w = pk2x<4>(o1[2], o1[3]);
                    *(u32x4*)(mg + row * DM + col) = w; } }
    }
};
struct EpiResid {
    static constexpr bool PERM = false, AFTER_DRAIN = false;
    const float* base; float* of; bf16_t* ob; float* rowsq;
    __device__ __forceinline__ void operator()(const f32x4 (&acc)[2][2][4][2], const Unit& u, int wr, int wc, int fr, int fq) const {
        const int row0 = u.pm * 256 + wr * 64 + fr, col0 = u.pn * 256 + wc * 32 + 4 * fq;
#pragma unroll
        for (int ai = 0; ai < 2; ++ai)
#pragma unroll
            for (int m = 0; m < 4; ++m) { const size_t row = (size_t)(row0 + ai * 128 + m * 16); float ss = 0.f;
#pragma unroll
                for (int bj = 0; bj < 2; ++bj)
#pragma unroll
                    for (int n = 0; n < 2; ++n) { const size_t off = row * DM + col0 + bj * 128 + n * 16;
                        const f32x4 hv = *(const f32x4*)(base + off) + acc[ai][bj][m][n];
                        *(f32x4*)(of + off) = hv;
                        if (ob) { u32x2 w; w.x = pk2x<4>(hv[0], hv[1]); w.y = pk2x<4>(hv[2], hv[3]); *(u32x2*)(ob + off) = w; }
                        ss += (hv[0] * hv[0] + hv[1] * hv[1]) + (hv[2] * hv[2] + hv[3] * hv[3]); }
                ss += __shfl_xor(ss, 16); ss += __shfl_xor(ss, 32);
                if (rowsq && fq == 0) rowsq[row * 32 + u.pn * 4 + wc] = ss; }
    }
};
struct EpiFFN {
    static constexpr bool PERM = true, AFTER_DRAIN = false;
    bf16_t* ff; const float* rowsq;
    __device__ __forceinline__ void operator()(const f32x4 (&acc)[2][2][4][2], const Unit& u, int wr, int wc, int fr, int fq) const {
        const int row0 = u.pm * 256 + wr * 64 + fr, col0 = u.pn * 128 + wc * 32 + 8 * fq;
#pragma unroll
        for (int ai = 0; ai < 2; ++ai)
#pragma unroll
            for (int m = 0; m < 4; ++m) { const size_t row = (size_t)(row0 + ai * 128 + m * 16);
                float sq = 0.f;
#pragma unroll
                for (int q4 = 0; q4 < 8; ++q4) { const f32x4 t = *(const f32x4*)(rowsq + row * 32 + 4 * q4); sq += (t[0] + t[1]) + (t[2] + t[3]); }
                const float rs = rsqrtf(sq * (1.0f / DM) + EPS);
                float o[8];
#pragma unroll
                for (int n = 0; n < 2; ++n)
#pragma unroll
                    for (int j = 0; j < 4; ++j) { const float gt = acc[ai][0][m][n][j] * rs, up = acc[ai][1][m][n][j] * rs; o[n * 4 + j] = siluf_(gt) * up; }
                u32x4 w; w.x = pk2x<4>(o[0], o[1]); w.y = pk2x<4>(o[2], o[3]); w.z = pk2x<4>(o[4], o[5]); w.w = pk2x<4>(o[6], o[7]);
                *(u32x4*)(ff + row * DFF + col0) = w; }
    }
};

__device__ __forceinline__ void transpose_tile2(const float* __restrict__ W, int N, int K, bf16_t* WT_lo, size_t row_lo, bf16_t* WT_hi, size_t row_hi, const float* kscale, LAS unsigned* scr, int k0, int n0, int lane) {
    const int q = lane >> 4, c = lane & 15;
    f32x4 v[16];
    const bool ok = (n0 + 4 * c) < N;
#pragma unroll
    for (int i = 0; i < 16; ++i) { const int kk = 8 * (i >> 1) + 2 * q + (i & 1);
        v[i] = ok ? *(const f32x4*)(W + (size_t)(k0 + kk) * N + n0 + 4 * c) : (f32x4){0.f, 0.f, 0.f, 0.f}; }
    if (kscale) {
#pragma unroll
        for (int i = 0; i < 16; ++i) v[i] = v[i] * kscale[k0 + 8 * (i >> 1) + 2 * q + (i & 1)];
    }
#pragma unroll
    for (int m = 0; m < 8; ++m)
#pragma unroll
        for (int e = 0; e < 4; ++e) scr[(4 * c + e) * 33 + 4 * m + q] = pk2(v[2 * m][e], v[2 * m + 1][e]);
    LDS_WAIT();
    const int rr = lane >> 3, ch = lane & 7;
#pragma unroll
    for (int j = 0; j < 8; ++j) { const int n = 8 * j + rr; const LAS unsigned* sp = scr + n * 33 + 4 * ch;
        u32x4 o; o.x = sp[0]; o.y = sp[1]; o.z = sp[2]; o.w = sp[3];
        if (j < 4) { *(u32x4*)(WT_lo + (row_lo + n) * (size_t)K + k0 + 8 * ch) = o; }
        else if (WT_hi) { *(u32x4*)(WT_hi + (row_hi + (n - 32)) * (size_t)K + k0 + 8 * ch) = o; } }
    LDS_WAIT();
}
__device__ __forceinline__ void transpose_tile(const float* __restrict__ W, int N, int K, bf16_t* WT, size_t dst_row0, const float* kscale, LAS unsigned* scr, int k0, int n0, int lane) {
    transpose_tile2(W, N, K, WT, dst_row0, WT, dst_row0 + 32, kscale, scr, k0, n0, lane);
}
__device__ __forceinline__ float wave_sum(float v) {
#pragma unroll
    for (int o = 1; o < 64; o <<= 1) v += __shfl_xor(v, o);
    return v;
}
__device__ __forceinline__ void convert_late_weights(const Params& p, LAS unsigned char* lds, int gw, int NGW) {
    const int lane = threadIdx.x & 63, wave = __builtin_amdgcn_readfirstlane(threadIdx.x >> 6);
    LAS unsigned* scr = (LAS unsigned*)(lds + wave * 8448);
    unsigned char* ws = p.ws;
    constexpr int I_SQ = 32 * 32, I_GU = 32 * 88, I_D = 88 * 32;
    constexpr int NITEMS = 3 * I_SQ + 2 * I_GU + I_D;
    for (int it = gw; it < NITEMS; it += NGW) {
        int r = it;
        if (r < I_SQ) { const int kb = r / 32, nb = r % 32; transpose_tile(p.w_proj_a, DM, DM, (bf16_t*)(ws + WS_WA), (size_t)64 * nb, nullptr, scr, 64 * kb, 64 * nb, lane); continue; } r -= I_SQ;
        if (r < I_SQ) { const int kb = r / 32, nb = r % 32; transpose_tile(p.w_proj_b, DM, DM, (bf16_t*)(ws + WS_WB), (size_t)64 * nb, nullptr, scr, 64 * kb, 64 * nb, lane); continue; } r -= I_SQ;
        if (r < I_SQ) { const int kb = r / 32, nb = r % 32; transpose_tile(p.w_out, DM, DM, (bf16_t*)(ws + WS_WO), (size_t)64 * nb, nullptr, scr, 64 * kb, 64 * nb, lane); continue; } r -= I_SQ;
        if (r < I_GU) { const int kb = r / 88, nb = r % 88, n0 = 64 * nb; transpose_tile(p.w_gate, DFF, DM, (bf16_t*)(ws + WS_WGU), (size_t)((n0 >> 7) * 256 + (n0 & 127)), p.ln_ffn_g, scr, 64 * kb, n0, lane); continue; } r -= I_GU;
        if (r < I_GU) { const int kb = r / 88, nb = r % 88, n0 = 64 * nb; transpose_tile(p.w_up, DFF, DM, (bf16_t*)(ws + WS_WGU), (size_t)((n0 >> 7) * 256 + 128 + (n0 & 127)), p.ln_ffn_g, scr, 64 * kb, n0, lane); continue; } r -= I_GU;
        { const int kb = r / 32, nb = r % 32; transpose_tile(p.w_down, DM, DFF, (bf16_t*)(ws + WS_WD), (size_t)64 * nb, nullptr, scr, 64 * kb, 64 * nb, lane); }
    }
}
__device__ __forceinline__ void phase0(const Params& p, LAS unsigned char* lds) {
    const int tid = threadIdx.x, lane = tid & 63, wave = __builtin_amdgcn_readfirstlane(tid >> 6);
    const int gw = blockIdx.x * 8 + wave, NGW = gridDim.x * 8;
    LAS unsigned* scr = (LAS unsigned*)(lds + wave * 8448);
    unsigned char* ws = p.ws;
    constexpr int NT_IN = 289, I_IN = 32 * NT_IN;
    for (int it = gw; it < I_IN; it += NGW) { const int kb = it / NT_IN, nb = it % NT_IN; bf16_t* wt = (bf16_t*)(ws + WS_WIN);
        if (nb < 128)       transpose_tile(p.w_in, INW, DM, wt, (size_t)64 * nb, nullptr, scr, 64 * kb, 64 * nb, lane);
        else if (nb == 128) transpose_tile2(p.w_in, INW, DM, (bf16_t*)(ws + WS_WBA), 0, wt, 8192, nullptr, scr, 64 * kb, 64 * nb, lane);
        else if (nb < 288)  transpose_tile(p.w_in, INW, DM, wt, (size_t)64 * nb - 32, nullptr, scr, 64 * kb, 64 * nb, lane);
        else                transpose_tile2(p.w_in, INW, DM, wt, (size_t)64 * nb - 32, nullptr, 0, nullptr, scr, 64 * kb, 64 * nb, lane); }
    bf16_t* xn = (bf16_t*)(ws + WS_XN);
    for (int m = gw; m < MTOK; m += NGW) {
        const f32x4* xr = (const f32x4*)(p.x + (size_t)m * DM) + lane; const f32x4* gr = (const f32x4*)p.ln_mix_g + lane;
        f32x4 v[8]; float s = 0.f;
#pragma unroll
        for (int j = 0; j < 8; ++j) { v[j] = xr[64 * j]; s += (v[j][0] * v[j][0] + v[j][1] * v[j][1]) + (v[j][2] * v[j][2] + v[j][3] * v[j][3]); }
        const float rs = rsqrtf(wave_sum(s) * (1.0f / DM) + EPS);
        u32x2* o = (u32x2*)(xn + (size_t)m * DM) + lane;
#pragma unroll
        for (int j = 0; j < 8; ++j) { const f32x4 g = gr[64 * j]; u32x2 w; w.x = pk2(v[j][0] * rs * g[0], v[j][1] * rs * g[1]); w.y = pk2(v[j][2] * rs * g[2], v[j][3] * rs * g[3]); o[64 * j] = w; }
    }
}

__device__ __forceinline__ void conv4_rows(const bf16_t* base, int r0, int t0, const float* cw, float (&out)[4][8]) {
    float w[4][8];
#pragma unroll
    for (int i = 0; i < 4; ++i) { const f32x4 a = *(const f32x4*)(cw + i * 6144), b = *(const f32x4*)(cw + i * 6144 + 4);
        w[i][0] = a[0]; w[i][1] = a[1]; w[i][2] = a[2]; w[i][3] = a[3]; w[i][4] = b[0]; w[i][5] = b[1]; w[i][6] = b[2]; w[i][7] = b[3]; }
    float x[7][8];
#pragma unroll
    for (int i = 0; i < 7; ++i) { const int rr = r0 - 3 + i; u32x4 v = (u32x4){0u, 0u, 0u, 0u};
        if (t0 + rr >= 0) v = *(const u32x4*)(base + (ptrdiff_t)rr * LDP);
        x[i][0] = bflo(v.x); x[i][1] = bfhi(v.x); x[i][2] = bflo(v.y); x[i][3] = bfhi(v.y); x[i][4] = bflo(v.z); x[i][5] = bfhi(v.z); x[i][6] = bflo(v.w); x[i][7] = bfhi(v.w); }
#pragma unroll
    for (int r = 0; r < 4; ++r)
#pragma unroll
        for (int j = 0; j < 8; ++j) { const float y = (w[0][j] * x[r][j] + w[1][j] * x[r + 1][j]) + (w[2][j] * x[r + 2][j] + w[3][j] * x[r + 3][j]); out[r][j] = siluf_(y); }
}
constexpr int P2_GRP = 68608;
__device__ __forceinline__ void phase2(const Params& p, LAS unsigned char* lds) {
    const int tid = threadIdx.x, grp = __builtin_amdgcn_readfirstlane(tid >> 8), lane = tid & 63, wvg = __builtin_amdgcn_readfirstlane((tid >> 6) & 3); int gt = tid & 255;
    unsigned char* ws = p.ws;
    const bf16_t* proj = (const bf16_t*)(ws + WS_PROJ);
    LAS unsigned char* gl = lds + grp * P2_GRP;
    LAS float* kn = (LAS float*)gl; LAS float* qn = (LAS float*)(gl + 33792);
    LAS float* Am = (LAS float*)(gl + 33792);
    LAS float* sbeta = (LAS float*)(gl + 67584); LAS float* sgc = sbeta + 64; LAS float* srsw = sbeta + 128;
    for (int item = blockIdx.x; item < 1024; item += gridDim.x) {
        asm volatile("" : "+v"(gt));
        const int unit = item * 2 + grp;
        const int b = unit >> 9, h = (unit >> 5) & 15, n = unit & 31, t0 = n * 64;
        const bf16_t* prow = proj + ((size_t)b * SEQ + t0) * LDP;
        unsigned char* hand = ws + WS_HAND + (size_t)unit * HAND_UNIT;
        bf16_t* w_g = (bf16_t*)hand; bf16_t* qd_g = (bf16_t*)(hand + 16384); bf16_t* kdT_g = (bf16_t*)(hand + 32768); bf16_t* uT_g = (bf16_t*)(hand + 49152); bf16_t* at_g = (bf16_t*)(hand + 65536);
        if (wvg == 0) {
            const float* bap = (const float*)(ws + WS_BA) + ((size_t)b * SEQ + t0 + gt) * 32; const float bb = bap[h], aa = bap[16 + h];
            const float xs = aa + p.dt_bias[h]; const float sp = xs > 20.f ? xs : __logf(1.0f + __expf(xs));
            float g = -__expf(p.A_log[h]) * sp;
#pragma unroll
            for (int o = 1; o < 64; o <<= 1) { const float t = __shfl_up(g, o); if (lane >= o) g += t; }
            sbeta[gt] = sigmoidf_(bb); sgc[gt] = g;
            if (gt == 63) ((float*)(ws + WS_EGL))[unit] = __expf(g);
        }
        const int r0 = (gt >> 4) * 4, c0 = (gt & 15) * 8;
        float qv[4][8], kv[4][8]; float rnk[4];
        conv4_rows(prow + OFF_Q + h * 128 + c0, r0, t0, p.conv_qkv_w + OFF_Q + h * 128 + c0, qv);
        conv4_rows(prow + OFF_K + h * 128 + c0, r0, t0, p.conv_qkv_w + OFF_K + h * 128 + c0, kv);
#pragma unroll
        for (int r = 0; r < 4; ++r) { float sq = 0.f, sk = 0.f;
#pragma unroll
            for (int j = 0; j < 8; ++j) { sq += qv[r][j] * qv[r][j]; sk += kv[r][j] * kv[r][j]; }
#pragma unroll
            for (int o = 1; o < 16; o <<= 1) { sq += __shfl_xor(sq, o); sk += __shfl_xor(sk, o); }
            const float rq = rsqrtf(sq + EPS) * 0.08838834764831845f; rnk[r] = rsqrtf(sk + EPS);
#pragma unroll
            for (int j = 0; j < 8; ++j) { qv[r][j] *= rq; kv[r][j] *= rnk[r]; } }
        LDS_BARRIER();
        const float gcl = sgc[63];
        float ekl[4];
#pragma unroll
        for (int r = 0; r < 4; ++r) { const int row = r0 + r; const float gc = sgc[row], eg = __expf(gc); ekl[r] = __expf(gcl - gc);
            u32x4 wd;
            *(LAS f32x4*)(qn + row * 132 + c0) = (f32x4){qv[r][0], qv[r][1], qv[r][2], qv[r][3]}; *(LAS f32x4*)(qn + row * 132 + c0 + 4) = (f32x4){qv[r][4], qv[r][5], qv[r][6], qv[r][7]};
            *(LAS f32x4*)(kn + row * 132 + c0) = (f32x4){kv[r][0], kv[r][1], kv[r][2], kv[r][3]}; *(LAS f32x4*)(kn + row * 132 + c0 + 4) = (f32x4){kv[r][4], kv[r][5], kv[r][6], kv[r][7]};
            wd.x = pk2x<1>(qv[r][0] * eg, qv[r][1] * eg); wd.y = pk2x<1>(qv[r][2] * eg, qv[r][3] * eg); wd.z = pk2x<1>(qv[r][4] * eg, qv[r][5] * eg); wd.w = pk2x<1>(qv[r][6] * eg, qv[r][7] * eg);
            *(u32x4*)(qd_g + row * 128 + c0) = wd;
            if ((gt & 15) == 0) srsw[row] = rnk[r] * sbeta[row] * eg; }
#pragma unroll
        for (int j = 0; j < 8; ++j) { u32x2 w; w.x = pk2x<1>(kv[0][j] * ekl[0], kv[1][j] * ekl[1]); w.y = pk2x<1>(kv[2][j] * ekl[2], kv[3][j] * ekl[3]); *(u32x2*)(kdT_g + (c0 + j) * 64 + r0) = w; }
        LDS_BARRIER();
        {
            const int wv = wvg, lr = lane & 15, lq = lane >> 4;
            f32x4 aK[4], aQ[4];
#pragma unroll
            for (int jb = 0; jb < 4; ++jb) { aK[jb] = (f32x4){0.f, 0.f, 0.f, 0.f}; aQ[jb] = (f32x4){0.f, 0.f, 0.f, 0.f}; }
#pragma unroll 2
            for (int kk = 0; kk < 8; ++kk) {
                const f32x4 ka = *(const LAS f32x4*)(kn + (16 * wv + lr) * 132 + 16 * kk + 4 * lq), qa = *(const LAS f32x4*)(qn + (16 * wv + lr) * 132 + 16 * kk + 4 * lq);
#pragma unroll
                for (int jb = 0; jb < 4; ++jb) if (jb <= wv) {
                    const f32x4 kb = *(const LAS f32x4*)(kn + (16 * jb + lr) * 132 + 16 * kk + 4 * lq);
#pragma unroll
                    for (int e = 0; e < 4; ++e) { aK[jb] = __builtin_amdgcn_mfma_f32_16x16x4f32(ka[e], kb[e], aK[jb], 0, 0, 0); aQ[jb] = __builtin_amdgcn_mfma_f32_16x16x4f32(qa[e], kb[e], aQ[jb], 0, 0, 0); }
                }
            }
            LDS_BARRIER();
#pragma unroll
            for (int jb = 0; jb < 4; ++jb) {
                const int j = 16 * jb + lr; const float gcj = sgc[j];
#pragma unroll
                for (int r = 0; r < 4; ++r) { const int i = 16 * wv + 4 * lq + r;
                    const float dec = (i >= j) ? __expf(sgc[i] - gcj) : 0.f;
                    Am[i * 64 + j] = (i > j) ? sbeta[i] * aK[jb][r] * dec : 0.f;
                    at_g[i * 64 + j] = (bf16_t)(pk2x<1>(aQ[jb][r] * dec, 0.f) & 0xffffu); }
            }
        }
        float X[64];
        {
            const bool isv = wvg < 2; const int cc = gt & 127;
            const int col = (isv ? OFF_V : OFF_K) + h * 128 + cc;
            const float* cwp = p.conv_qkv_w + col;
            const float w0 = cwp[0], w1 = cwp[6144], w2 = cwp[2 * 6144], w3 = cwp[3 * 6144];
            const LAS float* scl = isv ? sbeta : srsw;
            const bf16_t* pc = prow + col;
            float x0 = 0.f, x1 = 0.f, x2 = 0.f;
            if (t0 > 0) { x0 = bf2f(pc[-3 * (ptrdiff_t)LDP]); x1 = bf2f(pc[-2 * (ptrdiff_t)LDP]); x2 = bf2f(pc[-(ptrdiff_t)LDP]); }
#pragma unroll
            for (int i = 0; i < 64; ++i) { const float x3 = bf2f(pc[(size_t)i * LDP]); const float y = (w0 * x0 + w1 * x1) + (w2 * x2 + w3 * x3); X[i] = siluf_(y) * scl[i]; x0 = x1; x1 = x2; x2 = x3; }
        }
        LDS_BARRIER();
#pragma unroll
        for (int i = 1; i < 64; ++i) {
            float xa = X[i], xb = 0.f;
#pragma unroll
            for (int j4 = 0; j4 < (i + 3) / 4; ++j4) {
                const f32x4 a = *(const LAS f32x4*)(Am + i * 64 + 4 * j4);
                if (j4 & 1) { xb -= a[0] * X[4 * j4]; xb -= a[1] * X[4 * j4 + 1]; xb -= a[2] * X[4 * j4 + 2]; xb -= a[3] * X[4 * j4 + 3]; }
                else        { xa -= a[0] * X[4 * j4]; xa -= a[1] * X[4 * j4 + 1]; xa -= a[2] * X[4 * j4 + 2]; xa -= a[3] * X[4 * j4 + 3]; }
            }
            X[i] = xa + xb;
        }
        if (wvg < 2) {
#pragma unroll
            for (int i8 = 0; i8 < 8; ++i8) { u32x4 w; w.x = pk2x<1>(X[8 * i8], X[8 * i8 + 1]); w.y = pk2x<1>(X[8 * i8 + 2], X[8 * i8 + 3]); w.z = pk2x<1>(X[8 * i8 + 4], X[8 * i8 + 5]); w.w = pk2x<1>(X[8 * i8 + 6], X[8 * i8 + 7]);
                *(u32x4*)(uT_g + (gt & 127) * 64 + 8 * i8) = w; }
        } else {
#pragma unroll
            for (int i = 0; i < 64; ++i) w_g[i * 128 + (gt & 127)] = (bf16_t)(pk2x<1>(X[i], 0.f) & 0xffffu);
        }
    }
}
__device__ __forceinline__ void phase2_mixer(const Params& p) {
    const int tid = threadIdx.x; unsigned char* ws = p.ws;
    {
        bf16_t* projw = (bf16_t*)(ws + WS_PROJ);
        for (int item = blockIdx.x; item < 512; item += gridDim.x) {
            const int idx = item * 512 + tid; const int c0 = (idx & 255) * 8, r8 = (idx >> 8) * 8; const int t = r8 & (SEQ - 1);
            float w[3][8];
#pragma unroll
            for (int i = 0; i < 3; ++i) { const f32x4 a = *(const f32x4*)(p.conv_sc_w + i * 2048 + c0), bq = *(const f32x4*)(p.conv_sc_w + i * 2048 + c0 + 4);
                w[i][0] = a[0]; w[i][1] = a[1]; w[i][2] = a[2]; w[i][3] = a[3]; w[i][4] = bq[0]; w[i][5] = bq[1]; w[i][6] = bq[2]; w[i][7] = bq[3]; }
            float p0[8], p1[8];
#pragma unroll
            for (int j = 0; j < 8; ++j) { p0[j] = 0.f; p1[j] = 0.f; }
            if (t > 0) {
                const bf16_t* ra = projw + (size_t)(r8 - 2) * LDP; const bf16_t* rb = projw + (size_t)(r8 - 1) * LDP;
                const u32x4 ca = *(const u32x4*)(ra + OFF_SC + c0), ha = *(const u32x4*)(ra + OFF_SH + c0), cb = *(const u32x4*)(rb + OFF_SC + c0), hb = *(const u32x4*)(rb + OFF_SH + c0);
                p0[0] = bflo(ca.x) * bflo(ha.x); p0[1] = bfhi(ca.x) * bfhi(ha.x); p0[2] = bflo(ca.y) * bflo(ha.y); p0[3] = bfhi(ca.y) * bfhi(ha.y);
                p0[4] = bflo(ca.z) * bflo(ha.z); p0[5] = bfhi(ca.z) * bfhi(ha.z); p0[6] = bflo(ca.w) * bflo(ha.w); p0[7] = bfhi(ca.w) * bfhi(ha.w);
                p1[0] = bflo(cb.x) * bflo(hb.x); p1[1] = bfhi(cb.x) * bfhi(hb.x); p1[2] = bflo(cb.y) * bflo(hb.y); p1[3] = bfhi(cb.y) * bfhi(hb.y);
                p1[4] = bflo(cb.z) * bflo(hb.z); p1[5] = bfhi(cb.z) * bfhi(hb.z); p1[6] = bflo(cb.w) * bflo(hb.w); p1[7] = bfhi(cb.w) * bfhi(hb.w);
            }
#pragma unroll
            for (int i = 0; i < 8; ++i) {
                bf16_t* rp = projw + (size_t)(r8 + i) * LDP;
                const u32x4 cv = *(const u32x4*)(rp + OFF_SC + c0), hv = *(const u32x4*)(rp + OFF_SH + c0), bv = *(const u32x4*)(rp + OFF_SB + c0);
                float p2[8], bb[8], o[8];
                p2[0] = bflo(cv.x) * bflo(hv.x); p2[1] = bfhi(cv.x) * bfhi(hv.x); p2[2] = bflo(cv.y) * bflo(hv.y); p2[3] = bfhi(cv.y) * bfhi(hv.y);
                p2[4] = bflo(cv.z) * bflo(hv.z); p2[5] = bfhi(cv.z) * bfhi(hv.z); p2[6] = bflo(cv.w) * bflo(hv.w); p2[7] = bfhi(cv.w) * bfhi(hv.w);
                bb[0] = bflo(bv.x); bb[1] = bfhi(bv.x); bb[2] = bflo(bv.y); bb[3] = bfhi(bv.y); bb[4] = bflo(bv.z); bb[5] = bfhi(bv.z); bb[6] = bflo(bv.w); bb[7] = bfhi(bv.w);
#pragma unroll
                for (int j = 0; j < 8; ++j) { o[j] = bb[j] * (w[0][j] * p0[j] + w[1][j] * p1[j] + w[2][j] * p2[j]); p0[j] = p1[j]; p1[j] = p2[j]; }
                u32x4 wv; wv.x = pk2x<3>(o[0], o[1]); wv.y = pk2x<3>(o[2], o[3]); wv.z = pk2x<3>(o[4], o[5]); wv.w = pk2x<3>(o[6], o[7]);
                *(u32x4*)(rp + OFF_SB + c0) = wv;
            }
        }
    }
}

__device__ __forceinline__ void phase3(const Params& p, LAS unsigned char* lds, bf16_t* oa_base, int oa_ld) {
    const int tid = threadIdx.x, l = tid & 63, wv = __builtin_amdgcn_readfirstlane(tid >> 6), lr = l & 15, lq = l >> 4, tb = wv & 3, vh = wv >> 2, db = wv;
    unsigned char* ws = p.ws;
    LAS bf16_t* ST = (LAS bf16_t*)lds;
    LAS bf16_t* vT = (LAS bf16_t*)(lds + 34816);
    LAS float* oL = (LAS float*)(lds + 53248);
    LAS float* ngL = (LAS float*)(lds + 87040);
    const int prw = tid >> 3, pcs = (tid & 7) * 16;
    for (int bh = blockIdx.x; bh < 64; bh += gridDim.x) {
        const int b = bh >> 4, h = bh & 15;
        __syncthreads();
        for (int i = tid; i < 34816 / 16; i += 512) ((LAS u32x4*)ST)[i] = (u32x4){0u, 0u, 0u, 0u};
        if (tid < 128) ngL[tid] = p.gdn_norm_g[tid];
        f32x4 accS[8];
#pragma unroll
        for (int v = 0; v < 8; ++v) accS[v] = (f32x4){0.f, 0.f, 0.f, 0.f};
        __syncthreads();
        const unsigned char* hand0 = ws + WS_HAND + (size_t)bh * 32 * HAND_UNIT;
        const float* egl_g = (const float*)(ws + WS_EGL) + bh * 32;
        const bf16_t* projz = (const bf16_t*)(ws + WS_PROJ); const unsigned zoff = (unsigned)((b * SEQ + prw) * LDP + OFF_Z + h * 128 + pcs);
        const unsigned ooff = (unsigned)((b * SEQ + prw) * oa_ld + h * 128 + pcs);
        const int o_wq = (16 * tb + lr) * 128 + 8 * lq, o_at = (16 * tb + lr) * 64 + 8 * lq, o_k = (16 * db + lr) * 64 + 8 * lq, o_u = (64 * vh + lr) * 64 + 16 * tb + 4 * lq;
        bf16x8 c_w[4], c_q[4], c_at[2], c_k[2], n_at[2], n_k[2]; u32x2 c_u[4]; u32x4 c_z[2]; float c_e, n_e;
#define P3_LOAD_A(nn) do { const bf16_t* hb_ = (const bf16_t*)(hand0 + (size_t)(nn) * HAND_UNIT); \
        _Pragma("unroll") for (int ks = 0; ks < 4; ++ks) { c_w[ks] = *(const bf16x8*)(hb_ + o_wq + 32 * ks); c_q[ks] = *(const bf16x8*)(hb_ + 8192 + o_wq + 32 * ks); } \
        _Pragma("unroll") for (int j = 0; j < 4; ++j) c_u[j] = *(const u32x2*)(hb_ + 24576 + o_u + 1024 * j); } while (0)
#define P3_LOAD_B(AT_, K_, E_, nn) do { const bf16_t* hb_ = (const bf16_t*)(hand0 + (size_t)(nn) * HAND_UNIT); \
        _Pragma("unroll") for (int ks = 0; ks < 2; ++ks) { AT_[ks] = *(const bf16x8*)(hb_ + 32768 + o_at + 32 * ks); K_[ks] = *(const bf16x8*)(hb_ + 16384 + o_k + 32 * ks); } \
        E_ = egl_g[nn]; } while (0)
#define P3_LOAD_Z(nn) do { const bf16_t* zp_ = projz + (zoff + (unsigned)(nn) * (64u * LDP)); c_z[0] = *(const u32x4*)zp_; c_z[1] = *(const u32x4*)(zp_ + 8); } while (0)
        P3_LOAD_A(0); P3_LOAD_B(c_at, c_k, c_e, 0); P3_LOAD_Z(0);
#define P3_PHASE_C(nc) do { \
            float o[16]; float ss = 0.f; \
            _Pragma("unroll") for (int q4 = 0; q4 < 4; ++q4) { const f32x4 t = *(const LAS f32x4*)(oL + prw * 132 + pcs + 4 * q4); o[4 * q4] = t[0]; o[4 * q4 + 1] = t[1]; o[4 * q4 + 2] = t[2]; o[4 * q4 + 3] = t[3]; \
                ss += (t[0] * t[0] + t[1] * t[1]) + (t[2] * t[2] + t[3] * t[3]); } \
            ss += __shfl_xor(ss, 1); ss += __shfl_xor(ss, 2); ss += __shfl_xor(ss, 4); \
            const float rs = rsqrtf(ss * (1.0f / 128.0f) + EPS); \
            float zf[16]; \
            zf[0] = bflo(c_z[0].x); zf[1] = bfhi(c_z[0].x); zf[2] = bflo(c_z[0].y); zf[3] = bfhi(c_z[0].y); zf[4] = bflo(c_z[0].z); zf[5] = bfhi(c_z[0].z); zf[6] = bflo(c_z[0].w); zf[7] = bfhi(c_z[0].w); \
            zf[8] = bflo(c_z[1].x); zf[9] = bfhi(c_z[1].x); zf[10] = bflo(c_z[1].y); zf[11] = bfhi(c_z[1].y); zf[12] = bflo(c_z[1].z); zf[13] = bfhi(c_z[1].z); zf[14] = bflo(c_z[1].w); zf[15] = bfhi(c_z[1].w); \
            _Pragma("unroll") for (int q4 = 0; q4 < 4; ++q4) { const f32x4 g = *(const LAS f32x4*)(ngL + pcs + 4 * q4); \
                _Pragma("unroll") for (int j = 0; j < 4; ++j) o[4 * q4 + j] = o[4 * q4 + j] * rs * g[j] * siluf_(zf[4 * q4 + j]); } \
            u32x4 w0, w1; \
            w0.x = pk2x<3>(o[0], o[1]); w0.y = pk2x<3>(o[2], o[3]); w0.z = pk2x<3>(o[4], o[5]); w0.w = pk2x<3>(o[6], o[7]); \
            w1.x = pk2x<3>(o[8], o[9]); w1.y = pk2x<3>(o[10], o[11]); w1.z = pk2x<3>(o[12], o[13]); w1.w = pk2x<3>(o[14], o[15]); \
            bf16_t* zp = oa_base + (ooff + (unsigned)(nc) * (64u * (unsigned)oa_ld)); *(u32x4*)zp = w0; *(u32x4*)(zp + 8) = w1; } while (0)
#define P3_STEP(n, WITH_C) do { \
            const int nn = (n) < 31 ? (n) + 1 : 31; \
            P3_LOAD_B(n_at, n_k, n_e, nn); \
            f32x4 accV[4], accO[4]; \
            _Pragma("unroll") for (int j = 0; j < 4; ++j) { accV[j] = (f32x4){0.f, 0.f, 0.f, 0.f}; accO[j] = (f32x4){0.f, 0.f, 0.f, 0.f}; } \
            _Pragma("unroll") for (int kh = 0; kh < 2; ++kh) { bf16x8 SB[4][2]; \
              _Pragma("unroll") for (int j = 0; j < 4; ++j) _Pragma("unroll") for (int k2 = 0; k2 < 2; ++k2) SB[j][k2] = *(const LAS bf16x8*)(ST + (16 * (4 * vh + j) + lr) * 136 + 32 * (2 * kh + k2) + 8 * lq); \
              _Pragma("unroll") for (int k2 = 0; k2 < 2; ++k2) _Pragma("unroll") for (int j = 0; j < 4; ++j) { accV[j] = MFMA16(c_w[2 * kh + k2], SB[j][k2], accV[j]); accO[j] = MFMA16(c_q[2 * kh + k2], SB[j][k2], accO[j]); } } \
            if (WITH_C) { P3_PHASE_C((n) - 1); P3_LOAD_Z(n); } \
            _Pragma("unroll") for (int j = 0; j < 4; ++j) { const int vb = 4 * vh + j; \
                const float v0 = bflo(c_u[j].x) - accV[j][0], v1 = bfhi(c_u[j].x) - accV[j][1], v2 = bflo(c_u[j].y) - accV[j][2], v3 = bfhi(c_u[j].y) - accV[j][3]; \
                u32x2 w; w.x = pk2x<2>(v0, v1); w.y = pk2x<2>(v2, v3); \
                *(LAS u32x2*)(vT + (16 * vb + lr) * 72 + 16 * tb + 4 * lq) = w; } \
            P3_LOAD_A(nn); \
            LDS_BARRIER(); \
            { bf16x8 VB[8][2]; \
              _Pragma("unroll") for (int vb = 0; vb < 8; ++vb) _Pragma("unroll") for (int ks = 0; ks < 2; ++ks) VB[vb][ks] = *(const LAS bf16x8*)(vT + (16 * vb + lr) * 72 + 32 * ks + 8 * lq); \
              _Pragma("unroll") for (int ks = 0; ks < 2; ++ks) if (ks == 0 || tb >= 2) { \
                  _Pragma("unroll") for (int j = 0; j < 4; ++j) accO[j] = MFMA16(c_at[ks], vh ? VB[4 + j][ks] : VB[j][ks], accO[j]); } \
              _Pragma("unroll") for (int vb = 0; vb < 8; ++vb) accS[vb] = accS[vb] * c_e; \
              _Pragma("unroll") for (int ks = 0; ks < 2; ++ks) _Pragma("unroll") for (int vb = 0; vb < 8; ++vb) accS[vb] = MFMA16(c_k[ks], VB[vb][ks], accS[vb]); } \
            _Pragma("unroll") for (int j = 0; j < 4; ++j) { const int vb = 4 * vh + j; \
                _Pragma("unroll") for (int r = 0; r < 4; ++r) oL[(16 * tb + 4 * lq + r) * 132 + 16 * vb + lr] = accO[j][r]; } \
            _Pragma("unroll") for (int vb = 0; vb < 8; ++vb) { u32x2 w; w.x = pk2x<2>(accS[vb][0], accS[vb][1]); w.y = pk2x<2>(accS[vb][2], accS[vb][3]); \
                *(LAS u32x2*)(ST + (16 * vb + lr) * 136 + 16 * db + 4 * lq) = w; } \
            LDS_BARRIER(); \
            c_at[0] = n_at[0]; c_at[1] = n_at[1]; c_k[0] = n_k[0]; c_k[1] = n_k[1]; c_e = n_e; } while (0)
        P3_STEP(0, false);
        for (int n = 1; n < 32; ++n) P3_STEP(n, true);
        P3_PHASE_C(31);
#undef P3_STEP
#undef P3_PHASE_C
#undef P3_LOAD_A
#undef P3_LOAD_B
#undef P3_LOAD_Z
    }
}

__device__ __forceinline__ void phase8(const Params& p) {
    const int tid = threadIdx.x, lane = tid & 63, wave = __builtin_amdgcn_readfirstlane(tid >> 6);
    const int gw = blockIdx.x * 8 + wave, NGW = gridDim.x * 8;
    for (int m = gw; m < MTOK; m += NGW) {
        f32x4* xr = (f32x4*)(p.out + (size_t)m * DM) + lane; const f32x4* gr = (const f32x4*)p.ln_final_g + lane;
        f32x4 v[8]; float s = 0.f;
#pragma unroll
        for (int j = 0; j < 8; ++j) { v[j] = xr[64 * j]; s += (v[j][0] * v[j][0] + v[j][1] * v[j][1]) + (v[j][2] * v[j][2] + v[j][3] * v[j][3]); }
        const float rs = rsqrtf(wave_sum(s) * (1.0f / DM) + EPS);
#pragma unroll
        for (int j = 0; j < 8; ++j) { const f32x4 g = gr[64 * j]; xr[64 * j] = v[j] * rs * g; }
    }
}

__device__ __forceinline__ void side_gemm_ba(const Params& p, LAS unsigned char* lds) {
    const int tid = threadIdx.x, l = tid & 63, w = __builtin_amdgcn_readfirstlane(tid >> 6), lr = l & 15, lq = l >> 4;
    const bf16_t* xn = (const bf16_t*)(p.ws + WS_XN); const bf16_t* wba = (const bf16_t*)(p.ws + WS_WBA); float* ba = (float*)(p.ws + WS_BA);
    LAS f32x4* red = (LAS f32x4*)lds;
    for (int rb = blockIdx.x; rb < MTOK / 32; rb += gridDim.x) {
        f32x4 acc[2][2];
#pragma unroll
        for (int i = 0; i < 2; ++i)
#pragma unroll
            for (int j = 0; j < 2; ++j) acc[i][j] = (f32x4){0.f, 0.f, 0.f, 0.f};
#pragma unroll 2
        for (int ks = 0; ks < 8; ++ks) {
            bf16x8 af[2], bfr[2];
#pragma unroll
            for (int i = 0; i < 2; ++i) { af[i] = *(const bf16x8*)(xn + (size_t)(32 * rb + 16 * i + lr) * DM + 256 * w + 32 * ks + 8 * lq); bfr[i] = *(const bf16x8*)(wba + (size_t)(16 * i + lr) * DM + 256 * w + 32 * ks + 8 * lq); }
#pragma unroll
            for (int i = 0; i < 2; ++i)
#pragma unroll
                for (int j = 0; j < 2; ++j) acc[i][j] = MFMA16(af[i], bfr[j], acc[i][j]);
        }
        __syncthreads();
#pragma unroll
        for (int i = 0; i < 2; ++i)
#pragma unroll
            for (int j = 0; j < 2; ++j) red[(w * 4 + i * 2 + j) * 64 + l] = acc[i][j];
        __syncthreads();
        if (w < 4) { const int ti = w >> 1, tj = w & 1; f32x4 sacc = (f32x4){0.f, 0.f, 0.f, 0.f};
#pragma unroll
            for (int ww = 0; ww < 8; ++ww) sacc = sacc + red[(ww * 4 + w) * 64 + l];
#pragma unroll
            for (int r = 0; r < 4; ++r) ba[(size_t)(32 * rb + 16 * ti + 4 * lq + r) * 32 + 16 * tj + lr] = sacc[r]; }
    }
    __syncthreads();
}

__global__ void __launch_bounds__(512, 2) hybrid_fwd(Params p) {
    extern __shared__ __attribute__((aligned(16))) unsigned char smem[];
    LAS unsigned char* lds = (LAS unsigned char*)smem;
    cg::grid_group grid = cg::this_grid();
    unsigned char* ws = p.ws;
    const int lo = p.ph_lo, hi = p.ph_hi, G = gridDim.x, c = blockIdx.x;
#define IN(k) (lo <= (k) && (k) < hi)
#define SEAM(k) do { if (IN(k) && IN((k) + 1)) grid.sync(); } while (0)
#ifndef DUP_MASK
#define DUP_MASK 0
#endif
#define NREP(k) (((DUP_MASK >> (k)) & 1) ? 2 : 1)
    if (IN(0)) for (int rep = 0; rep < NREP(0); ++rep) { phase0(p, lds); __syncthreads(); }
    SEAM(0);
    if (IN(1)) for (int rep = 0; rep < NREP(1); ++rep) { side_gemm_ba(p, lds); pg8::Gemm g{(const bf16_t*)(ws + WS_XN), (const bf16_t*)(ws + WS_WIN), MTOK, LDP, DM, DM}; pg8::StaticOrder S; S.init(MTOK, LDP, G, c);
        EpiProj E{(bf16_t*)(ws + WS_PROJ), LDP}; pg8::gemm_phase<EpiProj, pg8::StaticOrder>(lds, g, S, E, nullptr); }
    SEAM(1);
    if (IN(2)) { for (int rep = 0; rep < NREP(2); ++rep) { phase2(p, lds); __syncthreads(); } phase2_mixer(p); }
    SEAM(2);
    if (IN(3)) { if (NREP(3) == 2) { phase3(p, lds, (bf16_t*)p.out, DM); __syncthreads(); } phase3(p, lds, (bf16_t*)(ws + WS_PROJ) + OFF_Z, LDP);
        if (G > 64) { if (c >= 64) convert_late_weights(p, lds, (c - 64) * 8 + (int)(threadIdx.x >> 6), (G - 64) * 8); } else { __syncthreads(); convert_late_weights(p, lds, c * 8 + (int)(threadIdx.x >> 6), G * 8); } }
    SEAM(3);
    if (IN(4)) {
        { pg8::Gemm g{(const bf16_t*)(ws + WS_PROJ) + OFF_Z, (const bf16_t*)(ws + WS_WA), MTOK, DM, DM, LDP}; pg8::StaticOrder S; S.init(MTOK, DM, G, c);
          EpiMergeA E{(float*)(ws + WS_MA), (const bf16_t*)(ws + WS_PROJ)}; pg8::gemm_phase<EpiMergeA, pg8::StaticOrder>(lds, g, S, E, nullptr); }
        __syncthreads();
        { pg8::Gemm g{(const bf16_t*)(ws + WS_PROJ) + OFF_SB, (const bf16_t*)(ws + WS_WB), MTOK, DM, DM, LDP}; pg8::StaticOrder S; S.init(MTOK, DM, G, c);
          EpiMergeB E{(const float*)(ws + WS_MA), (bf16_t*)(ws + WS_MB), (const bf16_t*)(ws + WS_PROJ)}; pg8::gemm_phase<EpiMergeB, pg8::StaticOrder>(lds, g, S, E, nullptr); }
    }
    SEAM(4);
    if (IN(5)) { pg8::Gemm g{(const bf16_t*)(ws + WS_MB), (const bf16_t*)(ws + WS_WO), MTOK, DM, DM, DM}; pg8::StaticOrder S; S.init(MTOK, DM, G, c);
        EpiResid E{p.x, (float*)(ws + WS_H1F), (bf16_t*)(ws + WS_H1B), (float*)(ws + WS_RSQ1)}; pg8::gemm_phase<EpiResid, pg8::StaticOrder>(lds, g, S, E, nullptr); }
    SEAM(5);
    if (IN(6)) { pg8::Gemm g{(const bf16_t*)(ws + WS_H1B), (const bf16_t*)(ws + WS_WGU), MTOK, 2 * DFF, DM, DM}; pg8::StaticOrder S; S.init(MTOK, 2 * DFF, G, c);
        EpiFFN E{(bf16_t*)(ws + WS_FF), (const float*)(ws + WS_RSQ1)}; pg8::gemm_phase<EpiFFN, pg8::StaticOrder>(lds, g, S, E, nullptr); }
    SEAM(6);
    if (IN(7)) { pg8::Gemm g{(const bf16_t*)(ws + WS_FF), (const bf16_t*)(ws + WS_WD), MTOK, DM, DFF, DFF}; pg8::StaticOrder S; S.init(MTOK, DM, G, c);
        EpiResid E{(const float*)(ws + WS_H1F), p.out, nullptr, nullptr}; pg8::gemm_phase<EpiResid, pg8::StaticOrder>(lds, g, S, E, nullptr); }
    SEAM(7);
    if (IN(8)) phase8(p);
#undef IN
#undef SEAM
}

extern "C" void kernel_launch(void* const* d_in, const int* in_sizes, int n_in, void* d_out, int out_size, void* d_ws, size_t ws_size, hipStream_t stream) {
    constexpr int LDS_BYTES = 147456;
    static int grid = 0;
    if (grid == 0) {
        if (n_in != 16 || out_size != MTOK * DM || ws_size < WS_END) { fprintf(stderr, "kernel_launch: unexpected shapes (n_in %d out %d ws %zu need %zu)\n", n_in, out_size, ws_size, (size_t)WS_END); grid = -1; return; }
        int dev = 0, cus = 0, per_cu = 0;
        hipGetDevice(&dev); hipDeviceGetAttribute(&cus, hipDeviceAttributeMultiprocessorCount, dev);
        if (hipFuncSetAttribute((const void*)hybrid_fwd, hipFuncAttributeMaxDynamicSharedMemorySize, LDS_BYTES) != hipSuccess) { fprintf(stderr, "kernel_launch: hipFuncSetAttribute failed\n"); grid = -1; return; }
        if (hipOccupancyMaxActiveBlocksPerMultiprocessor(&per_cu, (const void*)hybrid_fwd, 512, LDS_BYTES) != hipSuccess || per_cu < 1) { fprintf(stderr, "kernel_launch: occupancy query says %d blocks per CU\n", per_cu); per_cu = 1; }
        (void)hipGetLastError();
        grid = cus * 1;
        fprintf(stderr, "kernel_launch: cus %d per_cu %d grid %d ws %zu need %zu\n", cus, per_cu, grid, ws_size, (size_t)WS_END);
    }
    if (grid < 0) return;
    Params p{};
    p.x = (const float*)d_in[0]; p.ln_mix_g = (const float*)d_in[1]; p.w_in = (const float*)d_in[2]; p.conv_qkv_w = (const float*)d_in[3]; p.A_log = (const float*)d_in[4]; p.dt_bias = (const float*)d_in[5];
    p.gdn_norm_g = (const float*)d_in[6]; p.w_proj_a = (const float*)d_in[7]; p.conv_sc_w = (const float*)d_in[8]; p.w_proj_b = (const float*)d_in[9]; p.w_out = (const float*)d_in[10]; p.ln_ffn_g = (const float*)d_in[11];
    p.w_gate = (const float*)d_in[12]; p.w_up = (const float*)d_in[13]; p.w_down = (const float*)d_in[14]; p.ln_final_g = (const float*)d_in[15];
    p.out = (float*)d_out; p.ws = (unsigned char*)d_ws;
#if N_LAUNCHES == 1
    p.ph_lo = 0; p.ph_hi = NPHASE;
    void* args[] = {&p};
    hipError_t e = hipLaunchCooperativeKernel((const void*)hybrid_fwd, dim3(grid), dim3(512), args, LDS_BYTES, stream);
    if (e != hipSuccess) fprintf(stderr, "kernel_launch: cooperative launch failed: %s (grid %d)\n", hipGetErrorString(e), grid);
#else
    for (int k = 0; k < NPHASE; ++k) { p.ph_lo = k; p.ph_hi = k + 1; hipLaunchKernelGGL(hybrid_fwd, dim3(grid), dim3(512), LDS_BYTES, stream, p); }
#endif
}
```

```cpp
#include <hip/hip_runtime.h>
#include <hip/hip_cooperative_groups.h>
#include <cstdio>
namespace cg = cooperative_groups;
#define N_LAUNCHES 1
#define TRUNC_MASK 0
#define DUP_MASK 0
namespace pg8 {
#define PG8_LAS __attribute__((address_space(3)))
typedef unsigned short bf16_t;
typedef short bf16x8 __attribute__((ext_vector_type(8)));
typedef float f32x4 __attribute__((ext_vector_type(4)));
typedef unsigned u32x4 __attribute__((ext_vector_type(4)));
constexpr int BM = 256, BK = 64, HALF = 128, HTB = HALF * BK * 2  , STAGE_BYTES = 8 * HTB, NXCD = 8, WGM = 8;

__host__ __device__ __forceinline__ int lds_byte(int r, int c) { const int st = (r >> 4) * 2 + (c >> 5), rr = r & 15, cc = c & 31, ob = rr * 64 + cc * 2; return st * 1024 + (ob ^ (((ob >> 9) & 1) << 5)); }
__host__ __device__ __forceinline__ void stage_rc(int b, int& R, int& C) { const int st = b / 1024, sb = b % 1024, swz = sb ^ (((sb >> 9) & 1) << 5); R = (st >> 1) * 16 + swz / 64; C = (st & 1) * 32 + (swz % 64) / 2; }
__host__ __device__ __forceinline__ int perm32(int rho) { const int n = rho >> 4, i = rho & 15; return 8 * (i >> 2) + 4 * n + (i & 3); }

struct Unit { int pm, pn; };
struct Gemm { const bf16_t* A; const bf16_t* Bt; int M, N, K, lda; };

struct StaticOrder {
    int nM, nN, nwg, G, c;
    __host__ __device__ void init(int M, int N, int G_, int c_) { nM = M / BM; nN = N / BM; nwg = nM * nN; G = G_; c = c_; }
    __host__ __device__ bool next(int i, Unit& u) const {
        const long L = (long)i * G + c; if (L >= nwg) return false;
        int wgid = (int)L; { const int q = nwg / NXCD, r = nwg % NXCD, xcd = wgid % NXCD, off = wgid / NXCD; wgid = (xcd < r ? xcd * (q + 1) : r * (q + 1) + (xcd - r) * q) + off; }
        const int nig = WGM * nN, gid = wgid / nig, fm = gid * WGM, gsz = (nM - fm) < WGM ? (nM - fm) : WGM;
        u.pm = fm + ((wgid % nig) % gsz); u.pn = (wgid % nig) / gsz; return true;
    }
    __device__ __forceinline__ void a_ready(const Unit&) const {}
    __device__ __forceinline__ void done(const Unit&) const {}
};
__device__ __forceinline__ unsigned cvt_pk_bf16(float lo, float hi) { unsigned r; asm volatile("v_cvt_pk_bf16_f32 %0, %1, %2" : "=v"(r) : "v"(lo), "v"(hi)); return r; }
template <class Epi, class Sched, bool STAMP = false>
__device__ __forceinline__ void gemm_phase(PG8_LAS unsigned char* lds, const Gemm g, const Sched& S, const Epi& E, unsigned long long* stamps) {
    const int tid = threadIdx.x, wid = __builtin_amdgcn_readfirstlane(tid >> 6), lane = tid & 63, wr = wid >> 2, wc = wid & 3, fr = lane & 15, fq = lane >> 4;
    const int K = g.K, nt = K / BK;
    int ts_lo = 0, ts_hi = 0, nts = 0; const unsigned long long rt_entry = STAMP ? (unsigned long long)wall_clock64() : 0ull;
#define PG8_STAMP() do { if (STAMP && wid == 0 && nts < 64) { const unsigned long long _c = (unsigned long long)clock64(); \
        ts_lo = (lane == nts) ? (int)(unsigned)_c : ts_lo; ts_hi = (lane == nts) ? (int)(unsigned)(_c >> 32) : ts_hi; ++nts; } } while (0)
    PG8_STAMP();
    unsigned voffA[2], voffB[2];
#pragma unroll
    for (int i = 0; i < 2; ++i) { int R, C; stage_rc(tid * 16 + i * 8192, R, C); const int Rb = Epi::PERM ? ((R & ~31) + perm32(R & 31)) : R;
        voffA[i] = (unsigned)(R * g.lda + C) * 2u; voffB[i] = (unsigned)(Rb * K + C) * 2u; }
    const size_t kstep = (size_t)(BK * 2);
    const size_t hstepA = (size_t)HALF * g.lda * 2, hstepB = (size_t)HALF * K * 2;
    const size_t tstepA = 2 * hstepA, tstepB = 2 * hstepB;
    const unsigned ldsw = (unsigned)wid * 1024u;
    const int aoff = lds_byte(wr * 64 + fr, fq * 8), boff = lds_byte(wc * 32 + fr, fq * 8);
#define PG8_SA(b, h) (((b) * 2 + (h)) * HTB)
#define PG8_SB(b, h) ((4 + (b) * 2 + (h)) * HTB)
#define PG8_STAGE(bufoff, gbase, voff) do { _Pragma("unroll") for (int _i = 0; _i < 2; ++_i) \
        __builtin_amdgcn_global_load_lds((const unsigned*)((const char*)(gbase) + (voff)[_i]), (PG8_LAS unsigned*)(lds + (bufoff) + ldsw + _i * 8192), 16, 0, 0); } while (0)
#define PG8_LDA(dst, b, h) do { _Pragma("unroll") for (int m = 0; m < 4; ++m) _Pragma("unroll") for (int k = 0; k < 2; ++k) dst[m][k] = *(const PG8_LAS bf16x8*)(lds + PG8_SA(b, h) + aoff + m * 2048 + k * 1024); } while (0)
#define PG8_LDB(dst, b, h) do { _Pragma("unroll") for (int n = 0; n < 2; ++n) _Pragma("unroll") for (int k = 0; k < 2; ++k) dst[n][k] = *(const PG8_LAS bf16x8*)(lds + PG8_SB(b, h) + boff + n * 2048 + k * 1024); } while (0)
#define PG8_MMA(ai, bj, At, Bt) do { __builtin_amdgcn_s_setprio(1); _Pragma("unroll") for (int m = 0; m < 4; ++m) _Pragma("unroll") for (int n = 0; n < 2; ++n) _Pragma("unroll") for (int k = 0; k < 2; ++k) \
        acc[ai][bj][m][n] = __builtin_amdgcn_mfma_f32_16x16x32_bf16(Bt[n][k], At[m][k], acc[ai][bj][m][n], 0, 0, 0); __builtin_amdgcn_s_setprio(0); } while (0)
#define PG8_WAIT_V(n) asm volatile("s_waitcnt vmcnt(" #n ")" ::: "memory")
#define PG8_WAIT_L(n) asm volatile("s_waitcnt lgkmcnt(" #n ")" ::: "memory")
#define PG8_BAR __builtin_amdgcn_s_barrier()
#define PG8_SCHED __builtin_amdgcn_sched_barrier(0)
    Unit cur, nxt; int ui = 0;
    if (!S.next(0, cur)) return;
    f32x4 acc[2][2][4][2];
#pragma unroll
    for (int a = 0; a < 2; ++a)
#pragma unroll
        for (int b = 0; b < 2; ++b)
#pragma unroll
            for (int m = 0; m < 4; ++m)
#pragma unroll
                for (int n = 0; n < 2; ++n) acc[a][b][m][n] = (f32x4){0.f, 0.f, 0.f, 0.f};
    bf16x8 At[4][2], B0[2][2], B1[2][2];
    const char* cA = (const char*)g.A + (size_t)cur.pm * tstepA; const char* cB = (const char*)g.Bt + (size_t)cur.pn * tstepB;
    S.a_ready(cur);
    PG8_STAGE(PG8_SB(0, 0), cB, voffB); PG8_STAGE(PG8_SA(0, 0), cA, voffA); PG8_STAGE(PG8_SB(0, 1), cB + hstepB, voffB); PG8_STAGE(PG8_SA(0, 1), cA + hstepA, voffA);
    if (wr == 1) PG8_BAR;
    PG8_WAIT_V(4); PG8_BAR;
    PG8_STAGE(PG8_SB(1, 0), cB + kstep, voffB); PG8_STAGE(PG8_SA(1, 0), cA + kstep, voffA); PG8_STAGE(PG8_SB(1, 1), cB + hstepB + kstep, voffB);
    PG8_WAIT_V(6); PG8_BAR;
    PG8_STAMP();
    for (;;) {
        const bool has_next = S.next(ui + 1, nxt);
        const char* nA = has_next ? (const char*)g.A + (size_t)nxt.pm * tstepA : cA; const char* nB = has_next ? (const char*)g.Bt + (size_t)nxt.pn * tstepB : cB;
        for (int t = 0; t < nt; t += 2) {
            const bool last = (t == nt - 2);
            const char* a1 = cA + (size_t)(t + 1) * kstep;
            const char* a2 = last ? nA : cA + (size_t)(t + 2) * kstep; const char* b2 = last ? nB : cB + (size_t)(t + 2) * kstep;
            const char* a3 = a2 + kstep; const char* b3 = b2 + kstep;
            if (last && has_next) S.a_ready(nxt);
            PG8_LDB(B0, 0, 0); PG8_SCHED; PG8_LDA(At, 0, 0); PG8_STAGE(PG8_SA(1, 1), a1 + hstepA, voffA);
            PG8_WAIT_L(8); PG8_BAR; PG8_WAIT_L(0); PG8_MMA(0, 0, At, B0); PG8_BAR; PG8_SCHED;
            PG8_LDB(B1, 0, 1); PG8_STAGE(PG8_SB(0, 0), b2, voffB);
            PG8_BAR; PG8_WAIT_L(0); PG8_MMA(0, 1, At, B1); PG8_BAR;
            PG8_LDA(At, 0, 1); PG8_STAGE(PG8_SA(0, 0), a2, voffA);
            PG8_BAR; PG8_WAIT_L(0); PG8_MMA(1, 0, At, B0); PG8_BAR; PG8_SCHED;
            PG8_STAGE(PG8_SB(0, 1), b2 + hstepB, voffB);
            PG8_WAIT_V(6); PG8_BAR; PG8_MMA(1, 1, At, B1); PG8_BAR;
            PG8_LDB(B0, 1, 0); PG8_SCHED; PG8_LDA(At, 1, 0); PG8_STAGE(PG8_SA(0, 1), a2 + hstepA, voffA);
            PG8_WAIT_L(8); PG8_BAR; PG8_WAIT_L(0); PG8_MMA(0, 0, At, B0); PG8_BAR; PG8_SCHED;
            PG8_LDB(B1, 1, 1); PG8_STAGE(PG8_SB(1, 0), b3, voffB);
            PG8_BAR; PG8_WAIT_L(0); PG8_MMA(0, 1, At, B1); PG8_BAR;
            PG8_LDA(At, 1, 1); PG8_STAGE(PG8_SA(1, 0), a3, voffA);
            PG8_BAR; PG8_WAIT_L(0); PG8_MMA(1, 0, At, B0); PG8_BAR; PG8_SCHED;
            PG8_STAGE(PG8_SB(1, 1), b3 + hstepB, voffB);
            PG8_WAIT_V(6); PG8_BAR; PG8_MMA(1, 1, At, B1); PG8_BAR;
        }
        PG8_STAMP();
        if constexpr (!Epi::AFTER_DRAIN) { E(acc, cur, wr, wc, fr, fq); S.done(cur); }
        PG8_STAMP();
        if (!has_next) break;
#pragma unroll
        for (int a = 0; a < 2; ++a)
#pragma unroll
            for (int b = 0; b < 2; ++b)
#pragma unroll
                for (int m = 0; m < 4; ++m)
#pragma unroll
                    for (int n = 0; n < 2; ++n) acc[a][b][m][n] = (f32x4){0.f, 0.f, 0.f, 0.f};
        cur = nxt; cA = nA; cB = nB; ++ui;
    }
    PG8_WAIT_V(0);
    if (wr == 0) PG8_BAR;
    PG8_BAR;
    if constexpr (Epi::AFTER_DRAIN) { E.fused(acc, cur, wr, wc, fr, fq, lds, wid, lane); S.done(cur); }
    PG8_STAMP();
    if (STAMP && wid == 0) { stamps[lane] = lane < nts ? (((unsigned long long)(unsigned)ts_hi << 32) | (unsigned)ts_lo) : 0ull;
        if (lane == 62) stamps[62] = rt_entry; if (lane == 63) stamps[63] = (unsigned long long)wall_clock64(); }
#undef PG8_STAMP
#undef PG8_SA
#undef PG8_SB
#undef PG8_STAGE
#undef PG8_LDA
#undef PG8_LDB
#undef PG8_MMA
#undef PG8_WAIT_V
#undef PG8_WAIT_L
#undef PG8_BAR
#undef PG8_SCHED
}
}

#define LAS __attribute__((address_space(3)))
typedef unsigned short bf16_t;
typedef short bf16x8 __attribute__((ext_vector_type(8)));
typedef float f32x4 __attribute__((ext_vector_type(4)));
typedef unsigned u32x4 __attribute__((ext_vector_type(4)));
typedef unsigned u32x2 __attribute__((ext_vector_type(2)));

constexpr int MTOK = 8192, DM = 2048, SEQ = 2048, NH = 16, DFF = 5632, INW = 18464, LDP = 18432;
constexpr int OFF_Q = 0, OFF_K = 2048, OFF_V = 4096, OFF_Z = 6144, OFF_SB = 8192, OFF_SC = 10240, OFF_SH = 12288, OFF_GA = 14336, OFF_GB = 16384;
constexpr float EPS = 1e-6f;
constexpr int NPHASE = 9;
#ifndef N_LAUNCHES
#define N_LAUNCHES 1
#endif

constexpr size_t HAND_UNIT = 73728;
constexpr size_t WS_A0 = 0;
constexpr size_t WS_WIN = WS_A0, WS_XN = WS_A0 + (size_t)LDP * DM * 2;
constexpr size_t WS_HAND = WS_A0, WS_MA = WS_A0, WS_MB = WS_A0 + (size_t)MTOK * DM * 4;
constexpr size_t A0_BYTES = 2048 * HAND_UNIT;
constexpr size_t WS_PROJ = WS_A0 + A0_BYTES;
constexpr size_t WS_H1F = WS_PROJ, WS_H1B = WS_PROJ + (size_t)MTOK * DM * 4, WS_FF = WS_H1B + (size_t)MTOK * DM * 2;
constexpr size_t WS_WA = WS_PROJ + (size_t)MTOK * LDP * 2;
constexpr size_t WS_WB = WS_WA + (size_t)DM * DM * 2, WS_WO = WS_WB + (size_t)DM * DM * 2, WS_WGU = WS_WO + (size_t)DM * DM * 2;
constexpr size_t WS_WD = WS_WGU + (size_t)2 * DFF * DM * 2;
constexpr size_t WS_EGL = WS_WD + (size_t)DM * DFF * 2;
constexpr size_t WS_RSQ1 = WS_EGL + 2048 * 4, WS_WBA = WS_RSQ1 + (size_t)MTOK * 32 * 4, WS_BA = WS_WBA + (size_t)32 * DM * 2, WS_BAR = WS_BA + (size_t)MTOK * 32 * 4, WS_END = WS_BAR + 16384;
static_assert(WS_XN + (size_t)MTOK * DM * 2 <= A0_BYTES && WS_MB + (size_t)MTOK * DM * 2 <= A0_BYTES, "A0 overlays");
static_assert(WS_FF + (size_t)MTOK * DFF * 2 <= WS_WA, "proj overlays");

struct Params {
    const float *x, *ln_mix_g, *w_in, *conv_qkv_w, *A_log, *dt_bias, *gdn_norm_g, *w_proj_a, *conv_sc_w, *w_proj_b, *w_out, *ln_ffn_g, *w_gate, *w_up, *w_down, *ln_final_g;
    float* out; unsigned char* ws; int ph_lo, ph_hi;
};

__device__ __forceinline__ float bf2f(bf16_t u) { return __uint_as_float((unsigned)u << 16); }
__device__ __forceinline__ float bflo(unsigned w) { return __uint_as_float(w << 16); }
__device__ __forceinline__ float bfhi(unsigned w) { return __uint_as_float(w & 0xffff0000u); }
typedef float f32x2_t __attribute__((ext_vector_type(2)));
typedef __bf16 bf16x2_t __attribute__((ext_vector_type(2)));
__device__ __forceinline__ unsigned pk2(float lo, float hi) { const f32x2_t v = {lo, hi}; const bf16x2_t b = __builtin_convertvector(v, bf16x2_t); return __builtin_bit_cast(unsigned, b); }
#ifndef TRUNC_MASK
#define TRUNC_MASK 0
#endif
template <int K> __device__ __forceinline__ unsigned pk2x(float lo, float hi) {
    if ((TRUNC_MASK >> K) & 1) return (__float_as_uint(hi) & 0xffff0000u) | (__float_as_uint(lo) >> 16);
    return pk2(lo, hi);
}
__device__ __forceinline__ float sigmoidf_(float x) { return 1.0f / (1.0f + __expf(-x)); }
__device__ __forceinline__ float siluf_(float x) { return x / (1.0f + __expf(-x)); }
#define LDS_WAIT() asm volatile("s_waitcnt lgkmcnt(0)" ::: "memory")
#define LDS_BARRIER() do { asm volatile("s_waitcnt lgkmcnt(0)" ::: "memory"); __builtin_amdgcn_s_barrier(); asm volatile("" ::: "memory"); } while (0)
#define MFMA16(a, b, c) __builtin_amdgcn_mfma_f32_16x16x32_bf16(a, b, c, 0, 0, 0)

using pg8::Unit;
struct EpiProj {
    static constexpr bool PERM = true, AFTER_DRAIN = false;
    bf16_t* O; int ldc;
    __device__ __forceinline__ void operator()(const f32x4 (&acc)[2][2][4][2], const Unit& u, int wr, int wc, int fr, int fq) const {
        const int row0 = u.pm * 256 + wr * 64 + fr, col0 = u.pn * 256 + wc * 32 + 8 * fq;
#pragma unroll
        for (int ai = 0; ai < 2; ++ai)
#pragma unroll
            for (int m = 0; m < 4; ++m) { bf16_t* rowp = O + (size_t)(row0 + ai * 128 + m * 16) * ldc + col0;
#pragma unroll
                for (int bj = 0; bj < 2; ++bj) { const f32x4 v0 = acc[ai][bj][m][0], v1 = acc[ai][bj][m][1];
                    u32x4 w; w.x = pk2x<0>(v0[0], v0[1]); w.y = pk2x<0>(v0[2], v0[3]); w.z = pk2x<0>(v1[0], v1[1]); w.w = pk2x<0>(v1[2], v1[3]);
                    *(u32x4*)(rowp + bj * 128) = w; } }
    }
};
struct EpiMergeA {
    static constexpr bool PERM = true, AFTER_DRAIN = false;
    float* mA; const bf16_t* proj;
    __device__ __forceinline__ void operator()(const f32x4 (&acc)[2][2][4][2], const Unit& u, int wr, int wc, int fr, int fq) const {
        const int row0 = u.pm * 256 + wr * 64 + fr, col0 = u.pn * 256 + wc * 32 + 8 * fq;
#pragma unroll
        for (int ai = 0; ai < 2; ++ai)
#pragma unroll
            for (int m = 0; m < 4; ++m) { const size_t row = (size_t)(row0 + ai * 128 + m * 16);
#pragma unroll
                for (int bj = 0; bj < 2; ++bj) { const int col = col0 + bj * 128;
                    const u32x4 g = *(const u32x4*)(proj + row * LDP + OFF_GA + col);
                    const f32x4 v0 = acc[ai][bj][m][0], v1 = acc[ai][bj][m][1];
                    f32x4 o0, o1;
                    o0[0] = sigmoidf_(bflo(g.x)) * v0[0]; o0[1] = sigmoidf_(bfhi(g.x)) * v0[1]; o0[2] = sigmoidf_(bflo(g.y)) * v0[2]; o0[3] = sigmoidf_(bfhi(g.y)) * v0[3];
                    o1[0] = sigmoidf_(bflo(g.z)) * v1[0]; o1[1] = sigmoidf_(bfhi(g.z)) * v1[1]; o1[2] = sigmoidf_(bflo(g.w)) * v1[2]; o1[3] = sigmoidf_(bfhi(g.w)) * v1[3];
                    float* op = mA + row * DM + col; *(f32x4*)op = o0; *(f32x4*)(op + 4) = o1; } }
    }
};
struct EpiMergeB {
    static constexpr bool PERM = true, AFTER_DRAIN = false;
    const float* mA; bf16_t* mg; const bf16_t* proj;
    __device__ __forceinline__ void operator()(const f32x4 (&acc)[2][2][4][2], const Unit& u, int wr, int wc, int fr, int fq) const {
        const int row0 = u.pm * 256 + wr * 64 + fr, col0 = u.pn * 256 + wc * 32 + 8 * fq;
#pragma unroll
        for (int ai = 0; ai < 2; ++ai)
#pragma unroll
            for (int m = 0; m < 4; ++m) { const size_t row = (size_t)(row0 + ai * 128 + m * 16);
#pragma unroll
                for (int bj = 0; bj < 2; ++bj) { const int col = col0 + bj * 128;
                    const u32x4 g = *(const u32x4*)(proj + row * LDP + OFF_GB + col);
                    const float* ip = mA + row * DM + col; const f32x4 a0 = *(const f32x4*)ip, a1 = *(const f32x4*)(ip + 4);
                    const f32x4 v0 = acc[ai][bj][m][0], v1 = acc[ai][bj][m][1];
                    f32x4 o0, o1;
                    o0[0] = a0[0] + sigmoidf_(bflo(g.x)) * v0[0]; o0[1] = a0[1] + sigmoidf_(bfhi(g.x)) * v0[1]; o0[2] = a0[2] + sigmoidf_(bflo(g.y)) * v0[2]; o0[3] = a0[3] + sigmoidf_(bfhi(g.y)) * v0[3];
                    o1[0] = a1[0] + sigmoidf_(bflo(g.z)) * v1[0]; o1[1] = a1[1] + sigmoidf_(bfhi(g.z)) * v1[1]; o1[2] = a1[2] + sigmoidf_(bflo(g.w)) * v1[2]; o1[3] = a1[3] + sigmoidf_(bfhi(g.w)) * v1[3];
                    u32x4 w; w.x = pk2x<4>(o0[0], o0[1]); w.y = pk2x<4>(o0[2], o0[3]); w.z = pk2x<4>(o1[0], o1[1]); w.w = pk2x<4>(o1[2], o1[3]);
                    *(u32x4*)(mg + row * DM + col) = w; } }
    }
};
struct EpiResid {
    static constexpr bool PERM = false, AFTER_DRAIN = false;
    const float* base; float* of; bf16_t* ob; float* rowsq;
    __device__ __forceinline__ void operator()(const f32x4 (&acc)[2][2][4][2], const Unit& u, int wr, int wc, int fr, int fq) const {
        const int row0 = u.pm * 256 + wr * 64 + fr, col0 = u.pn * 256 + wc * 32 + 4 * fq;
#pragma unroll
        for (int ai = 0; ai < 2; ++ai)
#pragma unroll
            for (int m = 0; m < 4; ++m) { const size_t row = (size_t)(row0 + ai * 128 + m * 16); float ss = 0.f;
#pragma unroll
                for (int bj = 0; bj < 2; ++bj)
#pragma unroll
                    for (int n = 0; n < 2; ++n) { const size_t off = row * DM + col0 + bj * 128 + n * 16;
                        const f32x4 hv = *(const f32x4*)(base + off) + acc[ai][bj][m][n];
                        *(f32x4*)(of + off) = hv;
                        if (ob) { u32x2 w; w.x = pk2x<4>(hv[0], hv[1]); w.y = pk2x<4>(hv[2], hv[3]); *(u32x2*)(ob + off) = w; }
                        ss += (hv[0] * hv[0] + hv[1] * hv[1]) + (hv[2] * hv[2] + hv[3] * hv[3]); }
                ss += __shfl_xor(ss, 16); ss += __shfl_xor(ss, 32);
                if (rowsq && fq == 0) rowsq[row * 32 + u.pn * 4 + wc] = ss; }
    }
};
struct EpiFFN {
    static constexpr bool PERM = true, AFTER_DRAIN = false;
    bf16_t* ff; const float* rowsq;
    __device__ __forceinline__ void operator()(const f32x4 (&acc)[2][2][4][2], const Unit& u, int wr, int wc, int fr, int fq) const {
        const int row0 = u.pm * 256 + wr * 64 + fr, col0 = u.pn * 128 + wc * 32 + 8 * fq;
#pragma unroll
        for (int ai = 0; ai < 2; ++ai)
#pragma unroll
            for (int m = 0; m < 4; ++m) { const size_t row = (size_t)(row0 + ai * 128 + m * 16);
                float sq = 0.f;
#pragma unroll
                for (int q4 = 0; q4 < 8; ++q4) { const f32x4 t = *(const f32x4*)(rowsq + row * 32 + 4 * q4); sq += (t[0] + t[1]) + (t[2] + t[3]); }
                const float rs = rsqrtf(sq * (1.0f / DM) + EPS);
                float o[8];
#pragma unroll
                for (int n = 0; n < 2; ++n)
#pragma unroll
                    for (int j = 0; j < 4; ++j) { const float gt = acc[ai][0][m][n][j] * rs, up = acc[ai][1][m][n][j] * rs; o[n * 4 + j] = siluf_(gt) * up; }
                u32x4 w; w.x = pk2x<4>(o[0], o[1]); w.y = pk2x<4>(o[2], o[3]); w.z = pk2x<4>(o[4], o[5]); w.w = pk2x<4>(o[6], o[7]);
                *(u32x4*)(ff + row * DFF + col0) = w; }
    }
};

__device__ __forceinline__ void transpose_tile2(const float* __restrict__ W, int N, int K, bf16_t* WT_lo, size_t row_lo, bf16_t* WT_hi, size_t row_hi, const float* kscale, LAS unsigned* scr, int k0, int n0, int lane) {
    const int q = lane >> 4, c = lane & 15;
    f32x4 v[16];
    const bool ok = (n0 + 4 * c) < N;
#pragma unroll
    for (int i = 0; i < 16; ++i) { const int kk = 8 * (i >> 1) + 2 * q + (i & 1);
        v[i] = ok ? *(const f32x4*)(W + (size_t)(k0 + kk) * N + n0 + 4 * c) : (f32x4){0.f, 0.f, 0.f, 0.f}; }
    if (kscale) {
#pragma unroll
        for (int i = 0; i < 16; ++i) v[i] = v[i] * kscale[k0 + 8 * (i >> 1) + 2 * q + (i & 1)];
    }
#pragma unroll
    for (int m = 0; m < 8; ++m)
#pragma unroll
        for (int e = 0; e < 4; ++e) scr[(4 * c + e) * 33 + 4 * m + q] = pk2(v[2 * m][e], v[2 * m + 1][e]);
    LDS_WAIT();
    const int rr = lane >> 3, ch = lane & 7;
#pragma unroll
    for (int j = 0; j < 8; ++j) { const int n = 8 * j + rr; const LAS unsigned* sp = scr + n * 33 + 4 * ch;
        u32x4 o; o.x = sp[0]; o.y = sp[1]; o.z = sp[2]; o.w = sp[3];
        if (j < 4) { *(u32x4*)(WT_lo + (row_lo + n) * (size_t)K + k0 + 8 * ch) = o; }
        else if (WT_hi) { *(u32x4*)(WT_hi + (row_hi + (n - 32)) * (size_t)K + k0 + 8 * ch) = o; } }
    LDS_WAIT();
}
__device__ __forceinline__ void transpose_tile(const float* __restrict__ W, int N, int K, bf16_t* WT, size_t dst_row0, const float* kscale, LAS unsigned* scr, int k0, int n0, int lane) {
    transpose_tile2(W, N, K, WT, dst_row0, WT, dst_row0 + 32, kscale, scr, k0, n0, lane);
}
__device__ __forceinline__ float wave_sum(float v) {
#pragma unroll
    for (int o = 1; o < 64; o <<= 1) v += __shfl_xor(v, o);
    return v;
}
__device__ __forceinline__ void convert_late_weights(const Params& p, LAS unsigned char* lds, int gw, int NGW) {
    const int lane = threadIdx.x & 63, wave = __builtin_amdgcn_readfirstlane(threadIdx.x >> 6);
    LAS unsigned* scr = (LAS unsigned*)(lds + wave * 8448);
    unsigned char* ws = p.ws;
    constexpr int I_SQ = 32 * 32, I_GU = 32 * 88, I_D = 88 * 32;
    constexpr int NITEMS = 3 * I_SQ + 2 * I_GU + I_D;
    for (int it = gw; it < NITEMS; it += NGW) {
        int r = it;
        if (r < I_SQ) { const int kb = r / 32, nb = r % 32; transpose_tile(p.w_proj_a, DM, DM, (bf16_t*)(ws + WS_WA), (size_t)64 * nb, nullptr, scr, 64 * kb, 64 * nb, lane); continue; } r -= I_SQ;
        if (r < I_SQ) { const int kb = r / 32, nb = r % 32; transpose_tile(p.w_proj_b, DM, DM, (bf16_t*)(ws + WS_WB), (size_t)64 * nb, nullptr, scr, 64 * kb, 64 * nb, lane); continue; } r -= I_SQ;
        if (r < I_SQ) { const int kb = r / 32, nb = r % 32; transpose_tile(p.w_out, DM, DM, (bf16_t*)(ws + WS_WO), (size_t)64 * nb, nullptr, scr, 64 * kb, 64 * nb, lane); continue; } r -= I_SQ;
        if (r < I_GU) { const int kb = r / 88, nb = r % 88, n0 = 64 * nb; transpose_tile(p.w_gate, DFF, DM, (bf16_t*)(ws + WS_WGU), (size_t)((n0 >> 7) * 256 + (n0 & 127)), p.ln_ffn_g, scr, 64 * kb, n0, lane); continue; } r -= I_GU;
        if (r < I_GU) { const int kb = r / 88, nb = r % 88, n0 = 64 * nb; transpose_tile(p.w_up, DFF, DM, (bf16_t*)(ws + WS_WGU), (size_t)((n0 >> 7) * 256 + 128 + (n0 & 127)), p.ln_ffn_g, scr, 64 * kb, n0, lane); continue; } r -= I_GU;
        { const int kb = r / 32, nb = r % 32; transpose_tile(p.w_down, DM, DFF, (bf16_t*)(ws + WS_WD), (size_t)64 * nb, nullptr, scr, 64 * kb, 64 * nb, lane); }
    }
}
__device__ __forceinline__ void phase0(const Params& p, LAS unsigned char* lds) {
    const int tid = threadIdx.x, lane = tid & 63, wave = __builtin_amdgcn_readfirstlane(tid >> 6);
    const int gw = blockIdx.x * 8 + wave, NGW = gridDim.x * 8;
    LAS unsigned* scr = (LAS unsigned*)(lds + wave * 8448);
    unsigned char* ws = p.ws;
    constexpr int NT_IN = 289, I_IN = 32 * NT_IN;
    for (int it = gw; it < I_IN; it += NGW) { const int kb = it / NT_IN, nb = it % NT_IN; bf16_t* wt = (bf16_t*)(ws + WS_WIN);
        if (nb < 128)       transpose_tile(p.w_in, INW, DM, wt, (size_t)64 * nb, nullptr, scr, 64 * kb, 64 * nb, lane);
        else if (nb == 128) transpose_tile2(p.w_in, INW, DM, (bf16_t*)(ws + WS_WBA), 0, wt, 8192, nullptr, scr, 64 * kb, 64 * nb, lane);
        else if (nb < 288)  transpose_tile(p.w_in, INW, DM, wt, (size_t)64 * nb - 32, nullptr, scr, 64 * kb, 64 * nb, lane);
        else                transpose_tile2(p.w_in, INW, DM, wt, (size_t)64 * nb - 32, nullptr, 0, nullptr, scr, 64 * kb, 64 * nb, lane); }
    bf16_t* xn = (bf16_t*)(ws + WS_XN);
    for (int m = gw; m < MTOK; m += NGW) {
        const f32x4* xr = (const f32x4*)(p.x + (size_t)m * DM) + lane; const f32x4* gr = (const f32x4*)p.ln_mix_g + lane;
        f32x4 v[8]; float s = 0.f;
#pragma unroll
        for (int j = 0; j < 8; ++j) { v[j] = xr[64 * j]; s += (v[j][0] * v[j][0] + v[j][1] * v[j][1]) + (v[j][2] * v[j][2] + v[j][3] * v[j][3]); }
        const float rs = rsqrtf(wave_sum(s) * (1.0f / DM) + EPS);
        u32x2* o = (u32x2*)(xn + (size_t)m * DM) + lane;
#pragma unroll
        for (int j = 0; j < 8; ++j) { const f32x4 g = gr[64 * j]; u32x2 w; w.x = pk2(v[j][0] * rs * g[0], v[j][1] * rs * g[1]); w.y = pk2(v[j][2] * rs * g[2], v[j][3] * rs * g[3]); o[64 * j] = w; }
    }
}

__device__ __forceinline__ void conv4_rows(const bf16_t* base, int r0, int t0, const float* cw, float (&out)[4][8]) {
    float w[4][8];
#pragma unroll
    for (int i = 0; i < 4; ++i) { const f32x4 a = *(const f32x4*)(cw + i * 6144), b = *(const f32x4*)(cw + i * 6144 + 4);
        w[i][0] = a[0]; w[i][1] = a[1]; w[i][2] = a[2]; w[i][3] = a[3]; w[i][4] = b[0]; w[i][5] = b[1]; w[i][6] = b[2]; w[i][7] = b[3]; }
    float x[7][8];
#pragma unroll
    for (int i = 0; i < 7; ++i) { const int rr = r0 - 3 + i; u32x4 v = (u32x4){0u, 0u, 0u, 0u};
        if (t0 + rr >= 0) v = *(const u32x4*)(base + (ptrdiff_t)rr * LDP);
        x[i][0] = bflo(v.x); x[i][1] = bfhi(v.x); x[i][2] = bflo(v.y); x[i][3] = bfhi(v.y); x[i][4] = bflo(v.z); x[i][5] = bfhi(v.z); x[i][6] = bflo(v.w); x[i][7] = bfhi(v.w); }
#pragma unroll
    for (int r = 0; r < 4; ++r)
#pragma unroll
        for (int j = 0; j < 8; ++j) { const float y = (w[0][j] * x[r][j] + w[1][j] * x[r + 1][j]) + (w[2][j] * x[r + 2][j] + w[3][j] * x[r + 3][j]); out[r][j] = siluf_(y); }
}
constexpr int P2_GRP = 68608;
__device__ __forceinline__ void phase2(const Params& p, LAS unsigned char* lds) {
    const int tid = threadIdx.x, grp = __builtin_amdgcn_readfirstlane(tid >> 8), lane = tid & 63, wvg = __builtin_amdgcn_readfirstlane((tid >> 6) & 3); int gt = tid & 255;
    unsigned char* ws = p.ws;
    const bf16_t* proj = (const bf16_t*)(ws + WS_PROJ);
    LAS unsigned char* gl = lds + grp * P2_GRP;
    LAS float* kn = (LAS float*)gl; LAS float* qn = (LAS float*)(gl + 33792);
    LAS float* Am = (LAS float*)(gl + 33792);
    LAS float* sbeta = (LAS float*)(gl + 67584); LAS float* sgc = sbeta + 64; LAS float* srsw = sbeta + 128;
    for (int item = blockIdx.x; item < 1024; item += gridDim.x) {
        asm volatile("" : "+v"(gt));
        const int unit = item * 2 + grp;
        const int b = unit >> 9, h = (unit >> 5) & 15, n = unit & 31, t0 = n * 64;
        const bf16_t* prow = proj + ((size_t)b * SEQ + t0) * LDP;
        unsigned char* hand = ws + WS_HAND + (size_t)unit * HAND_UNIT;
        bf16_t* w_g = (bf16_t*)hand; bf16_t* qd_g = (bf16_t*)(hand + 16384); bf16_t* kdT_g = (bf16_t*)(hand + 32768); bf16_t* uT_g = (bf16_t*)(hand + 49152); bf16_t* at_g = (bf16_t*)(hand + 65536);
        if (wvg == 0) {
            const float* bap = (const float*)(ws + WS_BA) + ((size_t)b * SEQ + t0 + gt) * 32; const float bb = bap[h], aa = bap[16 + h];
            const float xs = aa + p.dt_bias[h]; const float sp = xs > 20.f ? xs : __logf(1.0f + __expf(xs));
            float g = -__expf(p.A_log[h]) * sp;
#pragma unroll
            for (int o = 1; o < 64; o <<= 1) { const float t = __shfl_up(g, o); if (lane >= o) g += t; }
            sbeta[gt] = sigmoidf_(bb); sgc[gt] = g;
            if (gt == 63) ((float*)(ws + WS_EGL))[unit] = __expf(g);
        }
        const int r0 = (gt >> 4) * 4, c0 = (gt & 15) * 8;
        float qv[4][8], kv[4][8]; float rnk[4];
        conv4_rows(prow + OFF_Q + h * 128 + c0, r0, t0, p.conv_qkv_w + OFF_Q + h * 128 + c0, qv);
        conv4_rows(prow + OFF_K + h * 128 + c0, r0, t0, p.conv_qkv_w + OFF_K + h * 128 + c0, kv);
#pragma unroll
        for (int r = 0; r < 4; ++r) { float sq = 0.f, sk = 0.f;
#pragma unroll
            for (int j = 0; j < 8; ++j) { sq += qv[r][j] * qv[r][j]; sk += kv[r][j] * kv[r][j]; }
#pragma unroll
            for (int o = 1; o < 16; o <<= 1) { sq += __shfl_xor(sq, o); sk += __shfl_xor(sk, o); }
            const float rq = rsqrtf(sq + EPS) * 0.08838834764831845f; rnk[r] = rsqrtf(sk + EPS);
#pragma unroll
            for (int j = 0; j < 8; ++j) { qv[r][j] *= rq; kv[r][j] *= rnk[r]; } }
        LDS_BARRIER();
        const float gcl = sgc[63];
        float ekl[4];
#pragma unroll
        for (int r = 0; r < 4; ++r) { const int row = r0 + r; const float gc = sgc[row], eg = __expf(gc); ekl[r] = __expf(gcl - gc);
            u32x4 wd;
            *(LAS f32x4*)(qn + row * 132 + c0) = (f32x4){qv[r][0], qv[r][1], qv[r][2], qv[r][3]}; *(LAS f32x4*)(qn + row * 132 + c0 + 4) = (f32x4){qv[r][4], qv[r][5], qv[r][6], qv[r][7]};
            *(LAS f32x4*)(kn + row * 132 + c0) = (f32x4){kv[r][0], kv[r][1], kv[r][2], kv[r][3]}; *(LAS f32x4*)(kn + row * 132 + c0 + 4) = (f32x4){kv[r][4], kv[r][5], kv[r][6], kv[r][7]};
            wd.x = pk2x<1>(qv[r][0] * eg, qv[r][1] * eg); wd.y = pk2x<1>(qv[r][2] * eg, qv[r][3] * eg); wd.z = pk2x<1>(qv[r][4] * eg, qv[r][5] * eg); wd.w = pk2x<1>(qv[r][6] * eg, qv[r][7] * eg);
            *(u32x4*)(qd_g + row * 128 + c0) = wd;
            if ((gt & 15) == 0) srsw[row] = rnk[r] * sbeta[row] * eg; }
#pragma unroll
        for (int j = 0; j < 8; ++j) { u32x2 w; w.x = pk2x<1>(kv[0][j] * ekl[0], kv[1][j] * ekl[1]); w.y = pk2x<1>(kv[2][j] * ekl[2], kv[3][j] * ekl[3]); *(u32x2*)(kdT_g + (c0 + j) * 64 + r0) = w; }
        LDS_BARRIER();
        {
            const int wv = wvg, lr = lane & 15, lq = lane >> 4;
            f32x4 aK[4], aQ[4];
#pragma unroll
            for (int jb = 0; jb < 4; ++jb) { aK[jb] = (f32x4){0.f, 0.f, 0.f, 0.f}; aQ[jb] = (f32x4){0.f, 0.f, 0.f, 0.f}; }
#pragma unroll 2
            for (int kk = 0; kk < 8; ++kk) {
                const f32x4 ka = *(const LAS f32x4*)(kn + (16 * wv + lr) * 132 + 16 * kk + 4 * lq), qa = *(const LAS f32x4*)(qn + (16 * wv + lr) * 132 + 16 * kk + 4 * lq);
#pragma unroll
                for (int jb = 0; jb < 4; ++jb) if (jb <= wv) {
                    const f32x4 kb = *(const LAS f32x4*)(kn + (16 * jb + lr) * 132 + 16 * kk + 4 * lq);
#pragma unroll
                    for (int e = 0; e < 4; ++e) { aK[jb] = __builtin_amdgcn_mfma_f32_16x16x4f32(ka[e], kb[e], aK[jb], 0, 0, 0); aQ[jb] = __builtin_amdgcn_mfma_f32_16x16x4f32(qa[e], kb[e], aQ[jb], 0, 0, 0); }
                }
            }
            LDS_BARRIER();
#pragma unroll
            for (int jb = 0; jb < 4; ++jb) {
                const int j = 16 * jb + lr; const float gcj = sgc[j];
#pragma unroll
                for (int r = 0; r < 4; ++r) { const int i = 16 * wv + 4 * lq + r;
                    const float dec = (i >= j) ? __expf(sgc[i] - gcj) : 0.f;
                    Am[i * 64 + j] = (i > j) ? sbeta[i] * aK[jb][r] * dec : 0.f;
                    at_g[i * 64 + j] = (bf16_t)(pk2x<1>(aQ[jb][r] * dec, 0.f) & 0xffffu); }
            }
        }
        float X[64];
        {
            const bool isv = wvg < 2; const int cc = gt & 127;
            const int col = (isv ? OFF_V : OFF_K) + h * 128 + cc;
            const float* cwp = p.conv_qkv_w + col;
            const float w0 = cwp[0], w1 = cwp[6144], w2 = cwp[2 * 6144], w3 = cwp[3 * 6144];
            const LAS float* scl = isv ? sbeta : srsw;
            const bf16_t* pc = prow + col;
            float x0 = 0.f, x1 = 0.f, x2 = 0.f;
            if (t0 > 0) { x0 = bf2f(pc[-3 * (ptrdiff_t)LDP]); x1 = bf2f(pc[-2 * (ptrdiff_t)LDP]); x2 = bf2f(pc[-(ptrdiff_t)LDP]); }
#pragma unroll
            for (int i = 0; i < 64; ++i) { const float x3 = bf2f(pc[(size_t)i * LDP]); const float y = (w0 * x0 + w1 * x1) + (w2 * x2 + w3 * x3); X[i] = siluf_(y) * scl[i]; x0 = x1; x1 = x2; x2 = x3; }
        }
        LDS_BARRIER();
#pragma unroll
        for (int i = 1; i < 64; ++i) {
            float xa = X[i], xb = 0.f;
#pragma unroll
            for (int j4 = 0; j4 < (i + 3) / 4; ++j4) {
                const f32x4 a = *(const LAS f32x4*)(Am + i * 64 + 4 * j4);
                if (j4 & 1) { xb -= a[0] * X[4 * j4]; xb -= a[1] * X[4 * j4 + 1]; xb -= a[2] * X[4 * j4 + 2]; xb -= a[3] * X[4 * j4 + 3]; }
                else        { xa -= a[0] * X[4 * j4]; xa -= a[1] * X[4 * j4 + 1]; xa -= a[2] * X[4 * j4 + 2]; xa -= a[3] * X[4 * j4 + 3]; }
            }
            X[i] = xa + xb;
        }
        if (wvg < 2) {
#pragma unroll
            for (int i8 = 0; i8 < 8; ++i8) { u32x4 w; w.x = pk2x<1>(X[8 * i8], X[8 * i8 + 1]); w.y = pk2x<1>(X[8 * i8 + 2], X[8 * i8 + 3]); w.z = pk2x<1>(X[8 * i8 + 4], X[8 * i8 + 5]); w.w = pk2x<1>(X[8 * i8 + 6], X[8 * i8 + 7]);
                *(u32x4*)(uT_g + (gt & 127) * 64 + 8 * i8) = w; }
        } else {
#pragma unroll
            for (int i = 0; i < 64; ++i) w_g[i * 128 + (gt & 127)] = (bf16_t)(pk2x<1>(X[i], 0.f) & 0xffffu);
        }
    }
}
__device__ __forceinline__ void phase2_mixer(const Params& p) {
    const int tid = threadIdx.x; unsigned char* ws = p.ws;
    {
        bf16_t* projw = (bf16_t*)(ws + WS_PROJ);
        for (int item = blockIdx.x; item < 512; item += gridDim.x) {
            const int idx = item * 512 + tid; const int c0 = (idx & 255) * 8, r8 = (idx >> 8) * 8; const int t = r8 & (SEQ - 1);
            float w[3][8];
#pragma unroll
            for (int i = 0; i < 3; ++i) { const f32x4 a = *(const f32x4*)(p.conv_sc_w + i * 2048 + c0), bq = *(const f32x4*)(p.conv_sc_w + i * 2048 + c0 + 4);
                w[i][0] = a[0]; w[i][1] = a[1]; w[i][2] = a[2]; w[i][3] = a[3]; w[i][4] = bq[0]; w[i][5] = bq[1]; w[i][6] = bq[2]; w[i][7] = bq[3]; }
            float p0[8], p1[8];
#pragma unroll
            for (int j = 0; j < 8; ++j) { p0[j] = 0.f; p1[j] = 0.f; }
            if (t > 0) {
                const bf16_t* ra = projw + (size_t)(r8 - 2) * LDP; const bf16_t* rb = projw + (size_t)(r8 - 1) * LDP;
                const u32x4 ca = *(const u32x4*)(ra + OFF_SC + c0), ha = *(const u32x4*)(ra + OFF_SH + c0), cb = *(const u32x4*)(rb + OFF_SC + c0), hb = *(const u32x4*)(rb + OFF_SH + c0);
                p0[0] = bflo(ca.x) * bflo(ha.x); p0[1] = bfhi(ca.x) * bfhi(ha.x); p0[2] = bflo(ca.y) * bflo(ha.y); p0[3] = bfhi(ca.y) * bfhi(ha.y);
                p0[4] = bflo(ca.z) * bflo(ha.z); p0[5] = bfhi(ca.z) * bfhi(ha.z); p0[6] = bflo(ca.w) * bflo(ha.w); p0[7] = bfhi(ca.w) * bfhi(ha.w);
                p1[0] = bflo(cb.x) * bflo(hb.x); p1[1] = bfhi(cb.x) * bfhi(hb.x); p1[2] = bflo(cb.y) * bflo(hb.y); p1[3] = bfhi(cb.y) * bfhi(hb.y);
                p1[4] = bflo(cb.z) * bflo(hb.z); p1[5] = bfhi(cb.z) * bfhi(hb.z); p1[6] = bflo(cb.w) * bflo(hb.w); p1[7] = bfhi(cb.w) * bfhi(hb.w);
            }
#pragma unroll
            for (int i = 0; i < 8; ++i) {
                bf16_t* rp = projw + (size_t)(r8 + i) * LDP;
                const u32x4 cv = *(const u32x4*)(rp + OFF_SC + c0), hv = *(const u32x4*)(rp + OFF_SH + c0), bv = *(const u32x4*)(rp + OFF_SB + c0);
                float p2[8], bb[8], o[8];
                p2[0] = bflo(cv.x) * bflo(hv.x); p2[1] = bfhi(cv.x) * bfhi(hv.x); p2[2] = bflo(cv.y) * bflo(hv.y); p2[3] = bfhi(cv.y) * bfhi(hv.y);
                p2[4] = bflo(cv.z) * bflo(hv.z); p2[5] = bfhi(cv.z) * bfhi(hv.z); p2[6] = bflo(cv.w) * bflo(hv.w); p2[7] = bfhi(cv.w) * bfhi(hv.w);
                bb[0] = bflo(bv.x); bb[1] = bfhi(bv.x); bb[2] = bflo(bv.y); bb[3] = bfhi(bv.y); bb[4] = bflo(bv.z); bb[5] = bfhi(bv.z); bb[6] = bflo(bv.w); bb[7] = bfhi(bv.w);
#pragma unroll
                for (int j = 0; j < 8; ++j) { o[j] = bb[j] * (w[0][j] * p0[j] + w[1][j] * p1[j] + w[2][j] * p2[j]); p0[j] = p1[j]; p1[j] = p2[j]; }
                u32x4 wv; wv.x = pk2x<3>(o[0], o[1]); wv.y = pk2x<3>(o[2], o[3]); wv.z = pk2x<3>(o[4], o[5]); wv.w = pk2x<3>(o[6], o[7]);
                *(u32x4*)(rp + OFF_SB + c0) = wv;
            }
        }
    }
}

__device__ __forceinline__ void phase3(const Params& p, LAS unsigned char* lds, bf16_t* oa_base, int oa_ld) {
    const int tid = threadIdx.x, l = tid & 63, wv = __builtin_amdgcn_readfirstlane(tid >> 6), lr = l & 15, lq = l >> 4, tb = wv & 3, vh = wv >> 2, db = wv;
    unsigned char* ws = p.ws;
    LAS bf16_t* ST = (LAS bf16_t*)lds;
    LAS bf16_t* vT = (LAS bf16_t*)(lds + 34816);
    LAS float* oL = (LAS float*)(lds + 53248);
    LAS float* ngL = (LAS float*)(lds + 87040);
    const int prw = tid >> 3, pcs = (tid & 7) * 16;
    for (int bh = blockIdx.x; bh < 64; bh += gridDim.x) {
        const int b = bh >> 4, h = bh & 15;
        __syncthreads();
        for (int i = tid; i < 34816 / 16; i += 512) ((LAS u32x4*)ST)[i] = (u32x4){0u, 0u, 0u, 0u};
        if (tid < 128) ngL[tid] = p.gdn_norm_g[tid];
        f32x4 accS[8];
#pragma unroll
        for (int v = 0; v < 8; ++v) accS[v] = (f32x4){0.f, 0.f, 0.f, 0.f};
        __syncthreads();
        const unsigned char* hand0 = ws + WS_HAND + (size_t)bh * 32 * HAND_UNIT;
        const float* egl_g = (const float*)(ws + WS_EGL) + bh * 32;
        const bf16_t* projz = (const bf16_t*)(ws + WS_PROJ); const unsigned zoff = (unsigned)((b * SEQ + prw) * LDP + OFF_Z + h * 128 + pcs);
        const unsigned ooff = (unsigned)((b * SEQ + prw) * oa_ld + h * 128 + pcs);
        const int o_wq = (16 * tb + lr) * 128 + 8 * lq, o_at = (16 * tb + lr) * 64 + 8 * lq, o_k = (16 * db + lr) * 64 + 8 * lq, o_u = (64 * vh + lr) * 64 + 16 * tb + 4 * lq;
        bf16x8 c_w[4], c_q[4], c_at[2], c_k[2], n_at[2], n_k[2]; u32x2 c_u[4]; u32x4 c_z[2]; float c_e, n_e;
#define P3_LOAD_A(nn) do { const bf16_t* hb_ = (const bf16_t*)(hand0 + (size_t)(nn) * HAND_UNIT); \
        _Pragma("unroll") for (int ks = 0; ks < 4; ++ks) { c_w[ks] = *(const bf16x8*)(hb_ + o_wq + 32 * ks); c_q[ks] = *(const bf16x8*)(hb_ + 8192 + o_wq + 32 * ks); } \
        _Pragma("unroll") for (int j = 0; j < 4; ++j) c_u[j] = *(const u32x2*)(hb_ + 24576 + o_u + 1024 * j); } while (0)
#define P3_LOAD_B(AT_, K_, E_, nn) do { const bf16_t* hb_ = (const bf16_t*)(hand0 + (size_t)(nn) * HAND_UNIT); \
        _Pragma("unroll") for (int ks = 0; ks < 2; ++ks) { AT_[ks] = *(const bf16x8*)(hb_ + 32768 + o_at + 32 * ks); K_[ks] = *(const bf16x8*)(hb_ + 16384 + o_k + 32 * ks); } \
        E_ = egl_g[nn]; } while (0)
#define P3_LOAD_Z(nn) do { const bf16_t* zp_ = projz + (zoff + (unsigned)(nn) * (64u * LDP)); c_z[0] = *(const u32x4*)zp_; c_z[1] = *(const u32x4*)(zp_ + 8); } while (0)
        P3_LOAD_A(0); P3_LOAD_B(c_at, c_k, c_e, 0); P3_LOAD_Z(0);
#define P3_PHASE_C(nc) do { \
            float o[16]; float ss = 0.f; \
            _Pragma("unroll") for (int q4 = 0; q4 < 4; ++q4) { const f32x4 t = *(const LAS f32x4*)(oL + prw * 132 + pcs + 4 * q4); o[4 * q4] = t[0]; o[4 * q4 + 1] = t[1]; o[4 * q4 + 2] = t[2]; o[4 * q4 + 3] = t[3]; \
                ss += (t[0] * t[0] + t[1] * t[1]) + (t[2] * t[2] + t[3] * t[3]); } \
            ss += __shfl_xor(ss, 1); ss += __shfl_xor(ss, 2); ss += __shfl_xor(ss, 4); \
            const float rs = rsqrtf(ss * (1.0f / 128.0f) + EPS); \
            float zf[16]; \
            zf[0] = bflo(c_z[0].x); zf[1] = bfhi(c_z[0].x); zf[2] = bflo(c_z[0].y); zf[3] = bfhi(c_z[0].y); zf[4] = bflo(c_z[0].z); zf[5] = bfhi(c_z[0].z); zf[6] = bflo(c_z[0].w); zf[7] = bfhi(c_z[0].w); \
            zf[8] = bflo(c_z[1].x); zf[9] = bfhi(c_z[1].x); zf[10] = bflo(c_z[1].y); zf[11] = bfhi(c_z[1].y); zf[12] = bflo(c_z[1].z); zf[13] = bfhi(c_z[1].z); zf[14] = bflo(c_z[1].w); zf[15] = bfhi(c_z[1].w); \
            _Pragma("unroll") for (int q4 = 0; q4 < 4; ++q4) { const f32x4 g = *(const LAS f32x4*)(ngL + pcs + 4 * q4); \
                _Pragma("unroll") for (int j = 0; j < 4; ++j) o[4 * q4 + j] = o[4 * q4 + j] * rs * g[j] * siluf_(zf[4 * q4 + j]); } \
            u32x4 w0, w1; \
            w0.x = pk2x<3>(o[0], o[1]); w0.y = pk2x<3>(o[2], o[3]); w0.z = pk2x<3>(o[4], o[5]); w0.w = pk2x<3>(o[6], o[7]); \
            w1.x = pk2x<3>(o[8], o[9]); w1.y = pk2x<3>(o[10], o[11]); w1.z = pk2x<3>(o[12], o[13]); w1.w = pk2x<3>(o[14], o[15]); \
            bf16_t* zp = oa_base + (ooff + (unsigned)(nc) * (64u * (unsigned)oa_ld)); *(u32x4*)zp = w0; *(u32x4*)(zp + 8) = w1; } while (0)
#define P3_STEP(n, WITH_C) do { \
            const int nn = (n) < 31 ? (n) + 1 : 31; \
            P3_LOAD_B(n_at, n_k, n_e, nn); \
            f32x4 accV[4], accO[4]; \
            _Pragma("unroll") for (int j = 0; j < 4; ++j) { accV[j] = (f32x4){0.f, 0.f, 0.f, 0.f}; accO[j] = (f32x4){0.f, 0.f, 0.f, 0.f}; } \
            _Pragma("unroll") for (int kh = 0; kh < 2; ++kh) { bf16x8 SB[4][2]; \
              _Pragma("unroll") for (int j = 0; j < 4; ++j) _Pragma("unroll") for (int k2 = 0; k2 < 2; ++k2) SB[j][k2] = *(const LAS bf16x8*)(ST + (16 * (4 * vh + j) + lr) * 136 + 32 * (2 * kh + k2) + 8 * lq); \
              _Pragma("unroll") for (int k2 = 0; k2 < 2; ++k2) _Pragma("unroll") for (int j = 0; j < 4; ++j) { accV[j] = MFMA16(c_w[2 * kh + k2], SB[j][k2], accV[j]); accO[j] = MFMA16(c_q[2 * kh + k2], SB[j][k2], accO[j]); } } \
            if (WITH_C) { P3_PHASE_C((n) - 1); P3_LOAD_Z(n); } \
            _Pragma("unroll") for (int j = 0; j < 4; ++j) { const int vb = 4 * vh + j; \
                const float v0 = bflo(c_u[j].x) - accV[j][0], v1 = bfhi(c_u[j].x) - accV[j][1], v2 = bflo(c_u[j].y) - accV[j][2], v3 = bfhi(c_u[j].y) - accV[j][3]; \
                u32x2 w; w.x = pk2x<2>(v0, v1); w.y = pk2x<2>(v2, v3); \
                *(LAS u32x2*)(vT + (16 * vb + lr) * 72 + 16 * tb + 4 * lq) = w; } \
            P3_LOAD_A(nn); \
            LDS_BARRIER(); \
            { bf16x8 VB[8][2]; \
              _Pragma("unroll") for (int vb = 0; vb < 8; ++vb) _Pragma("unroll") for (int ks = 0; ks < 2; ++ks) VB[vb][ks] = *(const LAS bf16x8*)(vT + (16 * vb + lr) * 72 + 32 * ks + 8 * lq); \
              _Pragma("unroll") for (int ks = 0; ks < 2; ++ks) if (ks == 0 || tb >= 2) { \
                  _Pragma("unroll") for (int j = 0; j < 4; ++j) accO[j] = MFMA16(c_at[ks], vh ? VB[4 + j][ks] : VB[j][ks], accO[j]); } \
              _Pragma("unroll") for (int vb = 0; vb < 8; ++vb) accS[vb] = accS[vb] * c_e; \
              _Pragma("unroll") for (int ks = 0; ks < 2; ++ks) _Pragma("unroll") for (int vb = 0; vb < 8; ++vb) accS[vb] = MFMA16(c_k[ks], VB[vb][ks], accS[vb]); } \
            _Pragma("unroll") for (int j = 0; j < 4; ++j) { const int vb = 4 * vh + j; \
                _Pragma("unroll") for (int r = 0; r < 4; ++r) oL[(16 * tb + 4 * lq + r) * 132 + 16 * vb + lr] = accO[j][r]; } \
            _Pragma("unroll") for (int vb = 0; vb < 8; ++vb) { u32x2 w; w.x = pk2x<2>(accS[vb][0], accS[vb][1]); w.y = pk2x<2>(accS[vb][2], accS[vb][3]); \
                *(LAS u32x2*)(ST + (16 * vb + lr) * 136 + 16 * db + 4 * lq) = w; } \
            LDS_BARRIER(); \
            c_at[0] = n_at[0]; c_at[1] = n_at[1]; c_k[0] = n_k[0]; c_k[1] = n_k[1]; c_e = n_e; } while (0)
        P3_STEP(0, false);
        for (int n = 1; n < 32; ++n) P3_STEP(n, true);
        P3_PHASE_C(31);
#undef P3_STEP
#undef P3_PHASE_C
#undef P3_LOAD_A
#undef P3_LOAD_B
#undef P3_LOAD_Z
    }
}

__device__ __forceinline__ void phase8(const Params& p) {
    const int tid = threadIdx.x, lane = tid & 63, wave = __builtin_amdgcn_readfirstlane(tid >> 6);
    const int gw = blockIdx.x * 8 + wave, NGW = gridDim.x * 8;
    for (int m = gw; m < MTOK; m += NGW) {
        f32x4* xr = (f32x4*)(p.out + (size_t)m * DM) + lane; const f32x4* gr = (const f32x4*)p.ln_final_g + lane;
        f32x4 v[8]; float s = 0.f;
#pragma unroll
        for (int j = 0; j < 8; ++j) { v[j] = xr[64 * j]; s += (v[j][0] * v[j][0] + v[j][1] * v[j][1]) + (v[j][2] * v[j][2] + v[j][3] * v[j][3]); }
        const float rs = rsqrtf(wave_sum(s) * (1.0f / DM) + EPS);
#pragma unroll
        for (int j = 0; j < 8; ++j) { const f32x4 g = gr[64 * j]; xr[64 * j] = v[j] * rs * g; }
    }
}

#define XB_TMO      128
#define XB_XCNT(j)  (256  + 64 * (j))
#define XB_XSUB(j)  (1280 + 64 * (j))
#define XB_XGEN(j)  (2304 + 64 * (j))
#define XB_TOP      3328
#define XB_TOPGEN   3392
#define XCD_BAR_WORDS 3456
#define XB_SPIN_CAP (1u << 18)
__device__ __forceinline__ unsigned xb_ld(unsigned* p)              { return __hip_atomic_load(p, __ATOMIC_RELAXED, __HIP_MEMORY_SCOPE_AGENT); }
__device__ __forceinline__ unsigned xb_add(unsigned* p, unsigned v) { return __hip_atomic_fetch_add(p, v, __ATOMIC_RELAXED, __HIP_MEMORY_SCOPE_AGENT); }
__device__ __forceinline__ unsigned xb_xcc_id() { return (unsigned)__builtin_amdgcn_s_getreg((3 << 11) | 20) & 0xFu; }
#define XB_SPIN(cond, bar) do { unsigned _sp = 0; while (cond) { __builtin_amdgcn_s_sleep(1); \
    if ((++_sp & 255u) == 0u) { if (xb_ld(&(bar)[XB_TMO])) break; if (_sp > XB_SPIN_CAP) { atomicAdd(&(bar)[XB_TMO], 1u); break; } } } } while (0)

struct XcdBarrier {
    unsigned* bar; unsigned x;
    volatile LAS unsigned* st;
};

__device__ __forceinline__ XcdBarrier xcd_barrier_post(unsigned* bar, volatile LAS unsigned* st) {
    XcdBarrier b; b.bar = bar; b.x = xb_xcc_id(); b.st = st;
    if (threadIdx.x == 0) (void)xb_add(&bar[XB_XCNT(b.x)], 1u);
    return b;
}
__device__ __forceinline__ void xcd_barrier_complete(unsigned* bar, unsigned x, unsigned& nloc, unsigned& nx) {
    const unsigned G = gridDim.x * gridDim.y * gridDim.z;
    unsigned sum, cnt, mine, sp = 0u;
    for (;;) {
        sum = 0u; cnt = 0u; mine = 0u;
#pragma unroll
        for (unsigned j = 0; j < 16; ++j) { const unsigned c = xb_ld(&bar[XB_XCNT(j)]); sum += c; cnt += (c > 0u) ? 1u : 0u; mine = (j == x) ? c : mine; }
        if (sum == G) break;
        __builtin_amdgcn_s_sleep(1);
        if ((++sp & 255u) == 0u) { if (xb_ld(&bar[XB_TMO])) break; if (sp > XB_SPIN_CAP) { atomicAdd(&bar[XB_TMO], 1u); break; } }
    }
    nloc = mine > 0u ? mine : 1u; nx = cnt > 0u ? cnt : 1u;
}

__device__ __forceinline__ void xcd_barrier(const XcdBarrier& b) {
    asm volatile("s_waitcnt vmcnt(0)" ::: "memory");
    __syncthreads();
    if (threadIdx.x == 0) {
        unsigned* bar = b.bar;
        __builtin_amdgcn_s_waitcnt(0);
        unsigned nloc = b.st[0], nx = b.st[1];
        if (nloc == 0u) { xcd_barrier_complete(bar, b.x, nloc, nx); b.st[0] = nloc; b.st[1] = nx; }
        const unsigned old = xb_add(&bar[XB_XSUB(b.x)], 1u);
        const unsigned gen = old / nloc;
        if (old + 1u == (gen + 1u) * nloc) {
            __builtin_amdgcn_fence(__ATOMIC_RELEASE, "agent");
            asm volatile("s_waitcnt vmcnt(0)" ::: "memory");
            const unsigned og = xb_add(&bar[XB_TOP], 1u);
            const unsigned tg = og / nx;
            if (og + 1u == (tg + 1u) * nx) xb_add(&bar[XB_TOPGEN], 1u);
            else XB_SPIN(xb_ld(&bar[XB_TOPGEN]) == tg, bar);
            __builtin_amdgcn_fence(__ATOMIC_ACQUIRE, "agent");
            xb_add(&bar[XB_XGEN(b.x)], 1u);
            asm volatile("s_waitcnt vmcnt(0)" ::: "memory");
        } else {
            XB_SPIN(xb_ld(&bar[XB_XGEN(b.x)]) == gen, bar);
            __builtin_amdgcn_fence(__ATOMIC_ACQUIRE, "agent");
            asm volatile("s_waitcnt vmcnt(0)" ::: "memory");
        }
    }
    __syncthreads();
}

__device__ __forceinline__ void side_gemm_ba(const Params& p, LAS unsigned char* lds) {
    const int tid = threadIdx.x, l = tid & 63, w = __builtin_amdgcn_readfirstlane(tid >> 6), lr = l & 15, lq = l >> 4;
    const bf16_t* xn = (const bf16_t*)(p.ws + WS_XN); const bf16_t* wba = (const bf16_t*)(p.ws + WS_WBA); float* ba = (float*)(p.ws + WS_BA);
    LAS f32x4* red = (LAS f32x4*)lds;
    for (int rb = blockIdx.x; rb < MTOK / 32; rb += gridDim.x) {
        f32x4 acc[2][2];
#pragma unroll
        for (int i = 0; i < 2; ++i)
#pragma unroll
            for (int j = 0; j < 2; ++j) acc[i][j] = (f32x4){0.f, 0.f, 0.f, 0.f};
#pragma unroll 2
        for (int ks = 0; ks < 8; ++ks) {
            bf16x8 af[2], bfr[2];
#pragma unroll
            for (int i = 0; i < 2; ++i) { af[i] = *(const bf16x8*)(xn + (size_t)(32 * rb + 16 * i + lr) * DM + 256 * w + 32 * ks + 8 * lq); bfr[i] = *(const bf16x8*)(wba + (size_t)(16 * i + lr) * DM + 256 * w + 32 * ks + 8 * lq); }
#pragma unroll
            for (int i = 0; i < 2; ++i)
#pragma unroll
                for (int j = 0; j < 2; ++j) acc[i][j] = MFMA16(af[i], bfr[j], acc[i][j]);
        }
        __syncthreads();
#pragma unroll
        for (int i = 0; i < 2; ++i)
#pragma unroll
            for (int j = 0; j < 2; ++j) red[(w * 4 + i * 2 + j) * 64 + l] = acc[i][j];
        __syncthreads();
        if (w < 4) { const int ti = w >> 1, tj = w & 1; f32x4 sacc = (f32x4){0.f, 0.f, 0.f, 0.f};
#pragma unroll
            for (int ww = 0; ww < 8; ++ww) sacc = sacc + red[(ww * 4 + w) * 64 + l];
#pragma unroll
            for (int r = 0; r < 4; ++r) ba[(size_t)(32 * rb + 16 * ti + 4 * lq + r) * 32 + 16 * tj + lr] = sacc[r]; }
    }
    __syncthreads();
}

__global__ void __launch_bounds__(512, 2) hybrid_fwd(Params p) {
    extern __shared__ __attribute__((aligned(16))) unsigned char smem[];
    LAS unsigned char* lds = (LAS unsigned char*)smem;
    cg::grid_group grid = cg::this_grid();
    unsigned char* ws = p.ws;
    const int lo = p.ph_lo, hi = p.ph_hi, G = gridDim.x, c = blockIdx.x;
#define IN(k) (lo <= (k) && (k) < hi)
    volatile LAS unsigned* xst = (volatile LAS unsigned*)(lds + 147440);
    if (threadIdx.x == 0) { xst[0] = 0u; xst[1] = 0u; }
    __syncthreads();
    XcdBarrier xb; xb.bar = (unsigned*)(ws + WS_BAR); xb.x = 0; xb.st = xst;
    if (hi - lo > 1) xb = xcd_barrier_post((unsigned*)(ws + WS_BAR), xst);
#define SEAM(k) do { if (IN(k) && IN((k) + 1)) { if ((k) == 0) grid.sync(); else xcd_barrier(xb); } } while (0)
#ifndef DUP_MASK
#define DUP_MASK 0
#endif
#define NREP(k) (((DUP_MASK >> (k)) & 1) ? 2 : 1)
    if (IN(0)) for (int rep = 0; rep < NREP(0); ++rep) { phase0(p, lds); __syncthreads(); }
    SEAM(0);
#ifdef EXTRA_SYNCS
    for (int e = 0; e < EXTRA_SYNCS; ++e) grid.sync();
#endif
    if (IN(1)) for (int rep = 0; rep < NREP(1); ++rep) { side_gemm_ba(p, lds); pg8::Gemm g{(const bf16_t*)(ws + WS_XN), (const bf16_t*)(ws + WS_WIN), MTOK, LDP, DM, DM}; pg8::StaticOrder S; S.init(MTOK, LDP, G, c);
        EpiProj E{(bf16_t*)(ws + WS_PROJ), LDP}; pg8::gemm_phase<EpiProj, pg8::StaticOrder>(lds, g, S, E, nullptr); }
    SEAM(1);
    if (IN(2)) { for (int rep = 0; rep < NREP(2); ++rep) { phase2(p, lds); __syncthreads(); } phase2_mixer(p); }
    SEAM(2);
    if (IN(3)) { if (NREP(3) == 2) { phase3(p, lds, (bf16_t*)p.out, DM); __syncthreads(); } phase3(p, lds, (bf16_t*)(ws + WS_PROJ) + OFF_Z, LDP);
        if (G > 64) { if (c >= 64) convert_late_weights(p, lds, (c - 64) * 8 + (int)(threadIdx.x >> 6), (G - 64) * 8); } else { __syncthreads(); convert_late_weights(p, lds, c * 8 + (int)(threadIdx.x >> 6), G * 8); } }
    SEAM(3);
    if (IN(4)) {
        { pg8::Gemm g{(const bf16_t*)(ws + WS_PROJ) + OFF_Z, (const bf16_t*)(ws + WS_WA), MTOK, DM, DM, LDP}; pg8::StaticOrder S; S.init(MTOK, DM, G, c);
          EpiMergeA E{(float*)(ws + WS_MA), (const bf16_t*)(ws + WS_PROJ)}; pg8::gemm_phase<EpiMergeA, pg8::StaticOrder>(lds, g, S, E, nullptr); }
        __syncthreads();
        { pg8::Gemm g{(const bf16_t*)(ws + WS_PROJ) + OFF_SB, (const bf16_t*)(ws + WS_WB), MTOK, DM, DM, LDP}; pg8::StaticOrder S; S.init(MTOK, DM, G, c);
          EpiMergeB E{(const float*)(ws + WS_MA), (bf16_t*)(ws + WS_MB), (const bf16_t*)(ws + WS_PROJ)}; pg8::gemm_phase<EpiMergeB, pg8::StaticOrder>(lds, g, S, E, nullptr); }
    }
    SEAM(4);
    if (IN(5)) { pg8::Gemm g{(const bf16_t*)(ws + WS_MB), (const bf16_t*)(ws + WS_WO), MTOK, DM, DM, DM}; pg8::StaticOrder S; S.init(MTOK, DM, G, c);
        EpiResid E{p.x, (float*)(ws + WS_H1F), (bf16_t*)(ws + WS_H1B), (float*)(ws + WS_RSQ1)}; pg8::gemm_phase<EpiResid, pg8::StaticOrder>(lds, g, S, E, nullptr); }
    SEAM(5);
    if (IN(6)) { pg8::Gemm g{(const bf16_t*)(ws + WS_H1B), (const bf16_t*)(ws + WS_WGU), MTOK, 2 * DFF, DM, DM}; pg8::StaticOrder S; S.init(MTOK, 2 * DFF, G, c);
        EpiFFN E{(bf16_t*)(ws + WS_FF), (const float*)(ws + WS_RSQ1)}; pg8::gemm_phase<EpiFFN, pg8::StaticOrder>(lds, g, S, E, nullptr); }
    SEAM(6);
    if (IN(7)) { pg8::Gemm g{(const bf16_t*)(ws + WS_FF), (const bf16_t*)(ws + WS_WD), MTOK, DM, DFF, DFF}; pg8::StaticOrder S; S.init(MTOK, DM, G, c);
        EpiResid E{(const float*)(ws + WS_H1F), p.out, nullptr, nullptr}; pg8::gemm_phase<EpiResid, pg8::StaticOrder>(lds, g, S, E, nullptr); }
    SEAM(7);
    if (IN(8)) phase8(p);
#undef IN
#undef SEAM
}

extern "C" void kernel_launch(void* const* d_in, const int* in_sizes, int n_in, void* d_out, int out_size, void* d_ws, size_t ws_size, hipStream_t stream) {
    constexpr int LDS_BYTES = 147456;
    static int grid = 0;
    if (grid == 0) {
        if (n_in != 16 || out_size != MTOK * DM || ws_size < WS_END) { fprintf(stderr, "kernel_launch: unexpected shapes (n_in %d out %d ws %zu need %zu)\n", n_in, out_size, ws_size, (size_t)WS_END); grid = -1; return; }
        int dev = 0, cus = 0, per_cu = 0;
        hipGetDevice(&dev); hipDeviceGetAttribute(&cus, hipDeviceAttributeMultiprocessorCount, dev);
        if (hipFuncSetAttribute((const void*)hybrid_fwd, hipFuncAttributeMaxDynamicSharedMemorySize, LDS_BYTES) != hipSuccess) { fprintf(stderr, "kernel_launch: hipFuncSetAttribute failed\n"); grid = -1; return; }
        if (hipOccupancyMaxActiveBlocksPerMultiprocessor(&per_cu, (const void*)hybrid_fwd, 512, LDS_BYTES) != hipSuccess || per_cu < 1) { fprintf(stderr, "kernel_launch: occupancy query says %d blocks per CU\n", per_cu); per_cu = 1; }
        (void)hipGetLastError();
        grid = cus * 1;
        fprintf(stderr, "kernel_launch: cus %d per_cu %d grid %d ws %zu need %zu\n", cus, per_cu, grid, ws_size, (size_t)WS_END);
    }
    if (grid < 0) return;
    Params p{};
    p.x = (const float*)d_in[0]; p.ln_mix_g = (const float*)d_in[1]; p.w_in = (const float*)d_in[2]; p.conv_qkv_w = (const float*)d_in[3]; p.A_log = (const float*)d_in[4]; p.dt_bias = (const float*)d_in[5];
    p.gdn_norm_g = (const float*)d_in[6]; p.w_proj_a = (const float*)d_in[7]; p.conv_sc_w = (const float*)d_in[8]; p.w_proj_b = (const float*)d_in[9]; p.w_out = (const float*)d_in[10]; p.ln_ffn_g = (const float*)d_in[11];
    p.w_gate = (const float*)d_in[12]; p.w_up = (const float*)d_in[13]; p.w_down = (const float*)d_in[14]; p.ln_final_g = (const float*)d_in[15];
    p.out = (float*)d_out; p.ws = (unsigned char*)d_ws;
#if N_LAUNCHES == 1
    p.ph_lo = 0; p.ph_hi = NPHASE;
    (void)hipMemsetAsync((char*)d_ws + WS_BAR, 0, XCD_BAR_WORDS * 4, stream);
    void* args[] = {&p};
    hipError_t e = hipLaunchCooperativeKernel((const void*)hybrid_fwd, dim3(grid), dim3(512), args, LDS_BYTES, stream);
    if (e != hipSuccess) fprintf(stderr, "kernel_launch: cooperative launch failed: %s (grid %d)\n", hipGetErrorString(e), grid);
#else
    for (int k = 0; k < NPHASE; ++k) { p.ph_lo = k; p.ph_hi = k + 1; hipLaunchKernelGGL(hybrid_fwd, dim3(grid), dim3(512), LDS_BYTES, stream, p); }
#endif
}
```

```cpp
#include <hip/hip_runtime.h>
#include <hip/hip_cooperative_groups.h>
#include <cstdio>
namespace cg = cooperative_groups;
#define N_LAUNCHES 1
#define TRUNC_MASK 0
#define DUP_MASK 0
namespace pg8 {
#define PG8_LAS __attribute__((address_space(3)))
typedef unsigned short bf16_t;
typedef short bf16x8 __attribute__((ext_vector_type(8)));
typedef float f32x4 __attribute__((ext_vector_type(4)));
typedef unsigned u32x4 __attribute__((ext_vector_type(4)));
constexpr int BM = 256, BK = 64, HALF = 128, HTB = HALF * BK * 2  , STAGE_BYTES = 8 * HTB, NXCD = 8, WGM = 8;

__host__ __device__ __forceinline__ int lds_byte(int r, int c) { const int st = (r >> 4) * 2 + (c >> 5), rr = r & 15, cc = c & 31, ob = rr * 64 + cc * 2; return st * 1024 + (ob ^ (((ob >> 9) & 1) << 5)); }
__host__ __device__ __forceinline__ void stage_rc(int b, int& R, int& C) { const int st = b / 1024, sb = b % 1024, swz = sb ^ (((sb >> 9) & 1) << 5); R = (st >> 1) * 16 + swz / 64; C = (st & 1) * 32 + (swz % 64) / 2; }
__host__ __device__ __forceinline__ int perm32(int rho) { const int n = rho >> 4, i = rho & 15; return 8 * (i >> 2) + 4 * n + (i & 3); }

struct Unit { int pm, pn; };
struct Gemm { const bf16_t* A; const bf16_t* Bt; int M, N, K, lda; };

struct StaticOrder {
    int nM, nN, nwg, G, c;
    __host__ __device__ void init(int M, int N, int G_, int c_) { nM = M / BM; nN = N / BM; nwg = nM * nN; G = G_; c = c_; }
    __host__ __device__ bool next(int i, Unit& u) const {
        const long L = (long)i * G + c; if (L >= nwg) return false;
        int wgid = (int)L; { const int q = nwg / NXCD, r = nwg % NXCD, xcd = wgid % NXCD, off = wgid / NXCD; wgid = (xcd < r ? xcd * (q + 1) : r * (q + 1) + (xcd - r) * q) + off; }
        const int nig = WGM * nN, gid = wgid / nig, fm = gid * WGM, gsz = (nM - fm) < WGM ? (nM - fm) : WGM;
        u.pm = fm + ((wgid % nig) % gsz); u.pn = (wgid % nig) / gsz; return true;
    }
    __device__ __forceinline__ void a_ready(const Unit&) const {}
    __device__ __forceinline__ void done(const Unit&) const {}
};
__device__ __forceinline__ unsigned cvt_pk_bf16(float lo, float hi) { unsigned r; asm volatile("v_cvt_pk_bf16_f32 %0, %1, %2" : "=v"(r) : "v"(lo), "v"(hi)); return r; }
template <class Epi, class Sched, bool STAMP = false>
__device__ __forceinline__ void gemm_phase(PG8_LAS unsigned char* lds, const Gemm g, const Sched& S, const Epi& E, unsigned long long* stamps) {
    const int tid = threadIdx.x, wid = __builtin_amdgcn_readfirstlane(tid >> 6), lane = tid & 63, wr = wid >> 2, wc = wid & 3, fr = lane & 15, fq = lane >> 4;
    const int K = g.K, nt = K / BK;
    int ts_lo = 0, ts_hi = 0, nts = 0; const unsigned long long rt_entry = STAMP ? (unsigned long long)wall_clock64() : 0ull;
#define PG8_STAMP() do { if (STAMP && wid == 0 && nts < 64) { const unsigned long long _c = (unsigned long long)clock64(); \
        ts_lo = (lane == nts) ? (int)(unsigned)_c : ts_lo; ts_hi = (lane == nts) ? (int)(unsigned)(_c >> 32) : ts_hi; ++nts; } } while (0)
    PG8_STAMP();
    unsigned voffA[2], voffB[2];
#pragma unroll
    for (int i = 0; i < 2; ++i) { int R, C; stage_rc(tid * 16 + i * 8192, R, C); const int Rb = Epi::PERM ? ((R & ~31) + perm32(R & 31)) : R;
        voffA[i] = (unsigned)(R * g.lda + C) * 2u; voffB[i] = (unsigned)(Rb * K + C) * 2u; }
    const size_t kstep = (size_t)(BK * 2);
    const size_t hstepA = (size_t)HALF * g.lda * 2, hstepB = (size_t)HALF * K * 2;
    const size_t tstepA = 2 * hstepA, tstepB = 2 * hstepB;
    const unsigned ldsw = (unsigned)wid * 1024u;
    const int aoff = lds_byte(wr * 64 + fr, fq * 8), boff = lds_byte(wc * 32 + fr, fq * 8);
#define PG8_SA(b, h) (((b) * 2 + (h)) * HTB)
#define PG8_SB(b, h) ((4 + (b) * 2 + (h)) * HTB)
#define PG8_STAGE(bufoff, gbase, voff) do { _Pragma("unroll") for (int _i = 0; _i < 2; ++_i) \
        __builtin_amdgcn_global_load_lds((const unsigned*)((const char*)(gbase) + (voff)[_i]), (PG8_LAS unsigned*)(lds + (bufoff) + ldsw + _i * 8192), 16, 0, 0); } while (0)
#define PG8_LDA(dst, b, h) do { _Pragma("unroll") for (int m = 0; m < 4; ++m) _Pragma("unroll") for (int k = 0; k < 2; ++k) dst[m][k] = *(const PG8_LAS bf16x8*)(lds + PG8_SA(b, h) + aoff + m * 2048 + k * 1024); } while (0)
#define PG8_LDB(dst, b, h) do { _Pragma("unroll") for (int n = 0; n < 2; ++n) _Pragma("unroll") for (int k = 0; k < 2; ++k) dst[n][k] = *(const PG8_LAS bf16x8*)(lds + PG8_SB(b, h) + boff + n * 2048 + k * 1024); } while (0)
#define PG8_MMA(ai, bj, At, Bt) do { __builtin_amdgcn_s_setprio(1); _Pragma("unroll") for (int m = 0; m < 4; ++m) _Pragma("unroll") for (int n = 0; n < 2; ++n) _Pragma("unroll") for (int k = 0; k < 2; ++k) \
        acc[ai][bj][m][n] = __builtin_amdgcn_mfma_f32_16x16x32_bf16(Bt[n][k], At[m][k], acc[ai][bj][m][n], 0, 0, 0); __builtin_amdgcn_s_setprio(0); } while (0)
#define PG8_WAIT_V(n) asm volatile("s_waitcnt vmcnt(" #n ")" ::: "memory")
#define PG8_WAIT_L(n) asm volatile("s_waitcnt lgkmcnt(" #n ")" ::: "memory")
#define PG8_BAR __builtin_amdgcn_s_barrier()
#define PG8_SCHED __builtin_amdgcn_sched_barrier(0)
    Unit cur, nxt; int ui = 0;
    if (!S.next(0, cur)) return;
    f32x4 acc[2][2][4][2];
#pragma unroll
    for (int a = 0; a < 2; ++a)
#pragma unroll
        for (int b = 0; b < 2; ++b)
#pragma unroll
            for (int m = 0; m < 4; ++m)
#pragma unroll
                for (int n = 0; n < 2; ++n) acc[a][b][m][n] = (f32x4){0.f, 0.f, 0.f, 0.f};
    bf16x8 At[4][2], B0[2][2], B1[2][2];
    const char* cA = (const char*)g.A + (size_t)cur.pm * tstepA; const char* cB = (const char*)g.Bt + (size_t)cur.pn * tstepB;
    S.a_ready(cur);
    PG8_STAGE(PG8_SB(0, 0), cB, voffB); PG8_STAGE(PG8_SA(0, 0), cA, voffA); PG8_STAGE(PG8_SB(0, 1), cB + hstepB, voffB); PG8_STAGE(PG8_SA(0, 1), cA + hstepA, voffA);
    if (wr == 1) PG8_BAR;
    PG8_WAIT_V(4); PG8_BAR;
    PG8_STAGE(PG8_SB(1, 0), cB + kstep, voffB); PG8_STAGE(PG8_SA(1, 0), cA + kstep, voffA); PG8_STAGE(PG8_SB(1, 1), cB + hstepB + kstep, voffB);
    PG8_WAIT_V(6); PG8_BAR;
    PG8_STAMP();
    for (;;) {
        const bool has_next = S.next(ui + 1, nxt);
        const char* nA = has_next ? (const char*)g.A + (size_t)nxt.pm * tstepA : cA; const char* nB = has_next ? (const char*)g.Bt + (size_t)nxt.pn * tstepB : cB;
        for (int t = 0; t < nt; t += 2) {
            const bool last = (t == nt - 2);
            const char* a1 = cA + (size_t)(t + 1) * kstep;
            const char* a2 = last ? nA : cA + (size_t)(t + 2) * kstep; const char* b2 = last ? nB : cB + (size_t)(t + 2) * kstep;
            const char* a3 = a2 + kstep; const char* b3 = b2 + kstep;
            if (last && has_next) S.a_ready(nxt);
            PG8_LDB(B0, 0, 0); PG8_SCHED; PG8_LDA(At, 0, 0); PG8_STAGE(PG8_SA(1, 1), a1 + hstepA, voffA);
            PG8_WAIT_L(8); PG8_BAR; PG8_WAIT_L(0); PG8_MMA(0, 0, At, B0); PG8_BAR; PG8_SCHED;
            PG8_LDB(B1, 0, 1); PG8_STAGE(PG8_SB(0, 0), b2, voffB);
            PG8_BAR; PG8_WAIT_L(0); PG8_MMA(0, 1, At, B1); PG8_BAR;
            PG8_LDA(At, 0, 1); PG8_STAGE(PG8_SA(0, 0), a2, voffA);
            PG8_BAR; PG8_WAIT_L(0); PG8_MMA(1, 0, At, B0); PG8_BAR; PG8_SCHED;
            PG8_STAGE(PG8_SB(0, 1), b2 + hstepB, voffB);
            PG8_WAIT_V(6); PG8_BAR; PG8_MMA(1, 1, At, B1); PG8_BAR;
            PG8_LDB(B0, 1, 0); PG8_SCHED; PG8_LDA(At, 1, 0); PG8_STAGE(PG8_SA(0, 1), a2 + hstepA, voffA);
            PG8_WAIT_L(8); PG8_BAR; PG8_WAIT_L(0); PG8_MMA(0, 0, At, B0); PG8_BAR; PG8_SCHED;
            PG8_LDB(B1, 1, 1); PG8_STAGE(PG8_SB(1, 0), b3, voffB);
            PG8_BAR; PG8_WAIT_L(0); PG8_MMA(0, 1, At, B1); PG8_BAR;
            PG8_LDA(At, 1, 1); PG8_STAGE(PG8_SA(1, 0), a3, voffA);
            PG8_BAR; PG8_WAIT_L(0); PG8_MMA(1, 0, At, B0); PG8_BAR; PG8_SCHED;
            PG8_STAGE(PG8_SB(1, 1), b3 + hstepB, voffB);
            PG8_WAIT_V(6); PG8_BAR; PG8_MMA(1, 1, At, B1); PG8_BAR;
        }
        PG8_STAMP();
        if constexpr (!Epi::AFTER_DRAIN) { E(acc, cur, wr, wc, fr, fq); S.done(cur); }
        PG8_STAMP();
        if (!has_next) break;
#pragma unroll
        for (int a = 0; a < 2; ++a)
#pragma unroll
            for (int b = 0; b < 2; ++b)
#pragma unroll
                for (int m = 0; m < 4; ++m)
#pragma unroll
                    for (int n = 0; n < 2; ++n) acc[a][b][m][n] = (f32x4){0.f, 0.f, 0.f, 0.f};
        cur = nxt; cA = nA; cB = nB; ++ui;
    }
    PG8_WAIT_V(0);
    if (wr == 0) PG8_BAR;
    PG8_BAR;
    if constexpr (Epi::AFTER_DRAIN) { E.fused(acc, cur, wr, wc, fr, fq, lds, wid, lane); S.done(cur); }
    PG8_STAMP();
    if (STAMP && wid == 0) { stamps[lane] = lane < nts ? (((unsigned long long)(unsigned)ts_hi << 32) | (unsigned)ts_lo) : 0ull;
        if (lane == 62) stamps[62] = rt_entry; if (lane == 63) stamps[63] = (unsigned long long)wall_clock64(); }
#undef PG8_STAMP
#undef PG8_SA
#undef PG8_SB
#undef PG8_STAGE
#undef PG8_LDA
#undef PG8_LDB
#undef PG8_MMA
#undef PG8_WAIT_V
#undef PG8_WAIT_L
#undef PG8_BAR
#undef PG8_SCHED
}
}

#define LAS __attribute__((address_space(3)))
typedef unsigned short bf16_t;
typedef short bf16x8 __attribute__((ext_vector_type(8)));
typedef float f32x4 __attribute__((ext_vector_type(4)));
typedef unsigned u32x4 __attribute__((ext_vector_type(4)));
typedef unsigned u32x2 __attribute__((ext_vector_type(2)));

constexpr int MTOK = 8192, DM = 2048, SEQ = 2048, NH = 16, DFF = 5632, INW = 18464, LDP = 18432;
constexpr int OFF_Q = 0, OFF_K = 2048, OFF_V = 4096, OFF_Z = 6144, OFF_SB = 8192, OFF_SC = 10240, OFF_SH = 12288, OFF_GA = 14336, OFF_GB = 16384;
constexpr float EPS = 1e-6f;
constexpr int NPHASE = 9;
#ifndef N_LAUNCHES
#define N_LAUNCHES 1
#endif

constexpr size_t HAND_UNIT = 73728;
constexpr size_t WS_A0 = 0;
constexpr size_t WS_WIN = WS_A0, WS_XN = WS_A0 + (size_t)LDP * DM * 2;
constexpr size_t WS_HAND = WS_A0, WS_MA = WS_A0, WS_MB = WS_A0 + (size_t)MTOK * DM * 4;
constexpr size_t A0_BYTES = 2048 * HAND_UNIT;
constexpr size_t WS_PROJ = WS_A0 + A0_BYTES;
constexpr size_t WS_H1F = WS_PROJ, WS_H1B = WS_PROJ + (size_t)MTOK * DM * 4, WS_FF = WS_H1B + (size_t)MTOK * DM * 2;
constexpr size_t WS_WA = WS_PROJ + (size_t)MTOK * LDP * 2;
constexpr size_t WS_WB = WS_WA + (size_t)DM * DM * 2, WS_WO = WS_WB + (size_t)DM * DM * 2, WS_WGU = WS_WO + (size_t)DM * DM * 2;
constexpr size_t WS_WD = WS_WGU + (size_t)2 * DFF * DM * 2;
constexpr size_t WS_EGL = WS_WD + (size_t)DM * DFF * 2;
constexpr size_t WS_RSQ1 = WS_EGL + 2048 * 4, WS_WBA = WS_RSQ1 + (size_t)MTOK * 32 * 4, WS_BA = WS_WBA + (size_t)32 * DM * 2, WS_BAR = WS_BA + (size_t)MTOK * 32 * 4, WS_END = WS_BAR + 16384;
static_assert(WS_XN + (size_t)MTOK * DM * 2 <= A0_BYTES && WS_MB + (size_t)MTOK * DM * 2 <= A0_BYTES, "A0 overlays");
static_assert(WS_FF + (size_t)MTOK * DFF * 2 <= WS_WA, "proj overlays");

struct Params {
    const float *x, *ln_mix_g, *w_in, *conv_qkv_w, *A_log, *dt_bias, *gdn_norm_g, *w_proj_a, *conv_sc_w, *w_proj_b, *w_out, *ln_ffn_g, *w_gate, *w_up, *w_down, *ln_final_g;
    float* out; unsigned char* ws; int ph_lo, ph_hi;
};

__device__ __forceinline__ float bf2f(bf16_t u) { return __uint_as_float((unsigned)u << 16); }
__device__ __forceinline__ float bflo(unsigned w) { return __uint_as_float(w << 16); }
__device__ __forceinline__ float bfhi(unsigned w) { return __uint_as_float(w & 0xffff0000u); }
typedef float f32x2_t __attribute__((ext_vector_type(2)));
typedef __bf16 bf16x2_t __attribute__((ext_vector_type(2)));
__device__ __forceinline__ unsigned pk2(float lo, float hi) { const f32x2_t v = {lo, hi}; const bf16x2_t b = __builtin_convertvector(v, bf16x2_t); return __builtin_bit_cast(unsigned, b); }
#ifndef TRUNC_MASK
#define TRUNC_MASK 0
#endif
template <int K> __device__ __forceinline__ unsigned pk2x(float lo, float hi) {
    if ((TRUNC_MASK >> K) & 1) return (__float_as_uint(hi) & 0xffff0000u) | (__float_as_uint(lo) >> 16);
    return pk2(lo, hi);
}
__device__ __forceinline__ float sigmoidf_(float x) { return 1.0f / (1.0f + __expf(-x)); }
__device__ __forceinline__ float siluf_(float x) { return x / (1.0f + __expf(-x)); }
#define LDS_WAIT() asm volatile("s_waitcnt lgkmcnt(0)" ::: "memory")
#define LDS_BARRIER() do { asm volatile("s_waitcnt lgkmcnt(0)" ::: "memory"); __builtin_amdgcn_s_barrier(); asm volatile("" ::: "memory"); } while (0)
#define MFMA16(a, b, c) __builtin_amdgcn_mfma_f32_16x16x32_bf16(a, b, c, 0, 0, 0)

using pg8::Unit;
struct EpiProj {
    static constexpr bool PERM = true, AFTER_DRAIN = false;
    bf16_t* O; int ldc;
    __device__ __forceinline__ void operator()(const f32x4 (&acc)[2][2][4][2], const Unit& u, int wr, int wc, int fr, int fq) const {
        const int row0 = u.pm * 256 + wr * 64 + fr, col0 = u.pn * 256 + wc * 32 + 8 * fq;
#pragma unroll
        for (int ai = 0; ai < 2; ++ai)
#pragma unroll
            for (int m = 0; m < 4; ++m) { bf16_t* rowp = O + (size_t)(row0 + ai * 128 + m * 16) * ldc + col0;
#pragma unroll
                for (int bj = 0; bj < 2; ++bj) { const f32x4 v0 = acc[ai][bj][m][0], v1 = acc[ai][bj][m][1];
                    u32x4 w; w.x = pk2x<0>(v0[0], v0[1]); w.y = pk2x<0>(v0[2], v0[3]); w.z = pk2x<0>(v1[0], v1[1]); w.w = pk2x<0>(v1[2], v1[3]);
                    *(u32x4*)(rowp + bj * 128) = w; } }
    }
};
struct EpiMergeA {
    static constexpr bool PERM = true, AFTER_DRAIN = false;
    float* mA; const bf16_t* proj;
    __device__ __forceinline__ void operator()(const f32x4 (&acc)[2][2][4][2], const Unit& u, int wr, int wc, int fr, int fq) const {
        const int row0 = u.pm * 256 + wr * 64 + fr, col0 = u.pn * 256 + wc * 32 + 8 * fq;
#pragma unroll
        for (int ai = 0; ai < 2; ++ai)
#pragma unroll
            for (int m = 0; m < 4; ++m) { const size_t row = (size_t)(row0 + ai * 128 + m * 16);
#pragma unroll
                for (int bj = 0; bj < 2; ++bj) { const int col = col0 + bj * 128;
                    const u32x4 g = *(const u32x4*)(proj + row * LDP + OFF_GA + col);
                    const f32x4 v0 = acc[ai][bj][m][0], v1 = acc[ai][bj][m][1];
                    f32x4 o0, o1;
                    o0[0] = sigmoidf_(bflo(g.x)) * v0[0]; o0[1] = sigmoidf_(bfhi(g.x)) * v0[1]; o0[2] = sigmoidf_(bflo(g.y)) * v0[2]; o0[3] = sigmoidf_(bfhi(g.y)) * v0[3];
                    o1[0] = sigmoidf_(bflo(g.z)) * v1[0]; o1[1] = sigmoidf_(bfhi(g.z)) * v1[1]; o1[2] = sigmoidf_(bflo(g.w)) * v1[2]; o1[3] = sigmoidf_(bfhi(g.w)) * v1[3];
                    float* op = mA + row * DM + col; *(f32x4*)op = o0; *(f32x4*)(op + 4) = o1; } }
    }
};
struct EpiMergeB {
    static constexpr bool PERM = true, AFTER_DRAIN = false;
    const float* mA; bf16_t* mg; const bf16_t* proj;
    __device__ __forceinline__ void operator()(const f32x4 (&acc)[2][2][4][2], const Unit& u, int wr, int wc, int fr, int fq) const {
        const int row0 = u.pm * 256 + wr * 64 + fr, col0 = u.pn * 256 + wc * 32 + 8 * fq;
#pragma unroll
        for (int ai = 0; ai < 2; ++ai)
#pragma unroll
            for (int m = 0; m < 4; ++m) { const size_t row = (size_t)(row0 + ai * 128 + m * 16);
#pragma unroll
                for (int bj = 0; bj < 2; ++bj) { const int col = col0 + bj * 128;
                    const u32x4 g = *(const u32x4*)(proj + row * LDP + OFF_GB + col);
                    const float* ip = mA + row * DM + col; const f32x4 a0 = *(const f32x4*)ip, a1 = *(const f32x4*)(ip + 4);
                    const f32x4 v0 = acc[ai][bj][m][0], v1 = acc[ai][bj][m][1];
                    f32x4 o0, o1;
                    o0[0] = a0[0] + sigmoidf_(bflo(g.x)) * v0[0]; o0[1] = a0[1] + sigmoidf_(bfhi(g.x)) * v0[1]; o0[2] = a0[2] + sigmoidf_(bflo(g.y)) * v0[2]; o0[3] = a0[3] + sigmoidf_(bfhi(g.y)) * v0[3];
                    o1[0] = a1[0] + sigmoidf_(bflo(g.z)) * v1[0]; o1[1] = a1[1] + sigmoidf_(bfhi(g.z)) * v1[1]; o1[2] = a1[2] + sigmoidf_(bflo(g.w)) * v1[2]; o1[3] = a1[3] + sigmoidf_(bfhi(g.w)) * v1[3];
                    u32x4 w; w.x = pk2x<4>(o0[0], o0[1]); w.y = pk2x<4>(o0[2], o0[3]); w.z = pk2x<4>(o1[0], o1[1]); w.w = pk2x<4>(o1[2], o1[3]);
                    *(u32x4*)(mg + row * DM + col) = w; } }
    }
};
struct EpiResid {
    static constexpr bool PERM = false, AFTER_DRAIN = false;
    const float* base; float* of; bf16_t* ob; float* rowsq;
    __device__ __forceinline__ void operator()(const f32x4 (&acc)[2][2][4][2], const Unit& u, int wr, int wc, int fr, int fq) const {
        const int row0 = u.pm * 256 + wr * 64 + fr, col0 = u.pn * 256 + wc * 32 + 4 * fq;
#pragma unroll
        for (int ai = 0; ai < 2; ++ai)
#pragma unroll
            for (int m = 0; m < 4; ++m) { const size_t row = (size_t)(row0 + ai * 128 + m * 16); float ss = 0.f;
#pragma unroll
                for (int bj = 0; bj < 2; ++bj)
#pragma unroll
                    for (int n = 0; n < 2; ++n) { const size_t off = row * DM + col0 + bj * 128 + n * 16;
                        const f32x4 hv = *(const f32x4*)(base + off) + acc[ai][bj][m][n];
                        *(f32x4*)(of + off) = hv;
                        if (ob) { u32x2 w; w.x = pk2x<4>(hv[0], hv[1]); w.y = pk2x<4>(hv[2], hv[3]); *(u32x2*)(ob + off) = w; }
                        ss += (hv[0] * hv[0] + hv[1] * hv[1]) + (hv[2] * hv[2] + hv[3] * hv[3]); }
                ss += __shfl_xor(ss, 16); ss += __shfl_xor(ss, 32);
                if (rowsq && fq == 0) rowsq[row * 32 + u.pn * 4 + wc] = ss; }
    }
};
struct EpiFFN {
    static constexpr bool PERM = true, AFTER_DRAIN = false;
    bf16_t* ff; const float* rowsq;
    __device__ __forceinline__ void operator()(const f32x4 (&acc)[2][2][4][2], const Unit& u, int wr, int wc, int fr, int fq) const {
        const int row0 = u.pm * 256 + wr * 64 + fr, col0 = u.pn * 128 + wc * 32 + 8 * fq;
#pragma unroll
        for (int ai = 0; ai < 2; ++ai)
#pragma unroll
            for (int m = 0; m < 4; ++m) { const size_t row = (size_t)(row0 + ai * 128 + m * 16);
                float sq = 0.f;
#pragma unroll
                for (int q4 = 0; q4 < 8; ++q4) { const f32x4 t = *(const f32x4*)(rowsq + row * 32 + 4 * q4); sq += (t[0] + t[1]) + (t[2] + t[3]); }
                const float rs = rsqrtf(sq * (1.0f / DM) + EPS);
                float o[8];
#pragma unroll
                for (int n = 0; n < 2; ++n)
#pragma unroll
                    for (int j = 0; j < 4; ++j) { const float gt = acc[ai][0][m][n][j] * rs, up = acc[ai][1][m][n][j] * rs; o[n * 4 + j] = siluf_(gt) * up; }
                u32x4 w; w.x = pk2x<4>(o[0], o[1]); w.y = pk2x<4>(o[2], o[3]); w.z = pk2x<4>(o[4], o[5]); w.w = pk2x<4>(o[6], o[7]);
                *(u32x4*)(ff + row * DFF + col0) = w; }
    }
};

__device__ __forceinline__ void transpose_tile2(const float* __restrict__ W, int N, int K, bf16_t* WT_lo, size_t row_lo, bf16_t* WT_hi, size_t row_hi, const float* kscale, LAS unsigned* scr, int k0, int n0, int lane) {
    const int q = lane >> 4, c = lane & 15;
    f32x4 v[16];
    const bool ok = (n0 + 4 * c) < N;
#pragma unroll
    for (int i = 0; i < 16; ++i) { const int kk = 8 * (i >> 1) + 2 * q + (i & 1);
        v[i] = ok ? *(const f32x4*)(W + (size_t)(k0 + kk) * N + n0 + 4 * c) : (f32x4){0.f, 0.f, 0.f, 0.f}; }
    if (kscale) {
#pragma unroll
        for (int i = 0; i < 16; ++i) v[i] = v[i] * kscale[k0 + 8 * (i >> 1) + 2 * q + (i & 1)];
    }
#pragma unroll
    for (int m = 0; m < 8; ++m)
#pragma unroll
        for (int e = 0; e < 4; ++e) scr[(4 * c + e) * 33 + 4 * m + q] = pk2(v[2 * m][e], v[2 * m + 1][e]);
    LDS_WAIT();
    const int rr = lane >> 3, ch = lane & 7;
#pragma unroll
    for (int j = 0; j < 8; ++j) { const int n = 8 * j + rr; const LAS unsigned* sp = scr + n * 33 + 4 * ch;
        u32x4 o; o.x = sp[0]; o.y = sp[1]; o.z = sp[2]; o.w = sp[3];
        if (j < 4) { *(u32x4*)(WT_lo + (row_lo + n) * (size_t)K + k0 + 8 * ch) = o; }
        else if (WT_hi) { *(u32x4*)(WT_hi + (row_hi + (n - 32)) * (size_t)K + k0 + 8 * ch) = o; } }
    LDS_WAIT();
}
__device__ __forceinline__ void transpose_tile(const float* __restrict__ W, int N, int K, bf16_t* WT, size_t dst_row0, const float* kscale, LAS unsigned* scr, int k0, int n0, int lane) {
    transpose_tile2(W, N, K, WT, dst_row0, WT, dst_row0 + 32, kscale, scr, k0, n0, lane);
}
__device__ __forceinline__ float wave_sum(float v) {
#pragma unroll
    for (int o = 1; o < 64; o <<= 1) v += __shfl_xor(v, o);
    return v;
}
__device__ __forceinline__ void convert_late_weights(const Params& p, LAS unsigned char* lds, int gw, int NGW) {
    const int lane = threadIdx.x & 63, wave = __builtin_amdgcn_readfirstlane(threadIdx.x >> 6);
    LAS unsigned* scr = (LAS unsigned*)(lds + wave * 8448);
    unsigned char* ws = p.ws;
    constexpr int I_SQ = 32 * 32, I_GU = 32 * 88, I_D = 88 * 32;
    constexpr int NITEMS = 3 * I_SQ + 2 * I_GU + I_D;
    for (int it = gw; it < NITEMS; it += NGW) {
        int r = it;
        if (r < I_SQ) { const int kb = r / 32, nb = r % 32; transpose_tile(p.w_proj_a, DM, DM, (bf16_t*)(ws + WS_WA), (size_t)64 * nb, nullptr, scr, 64 * kb, 64 * nb, lane); continue; } r -= I_SQ;
        if (r < I_SQ) { const int kb = r / 32, nb = r % 32; transpose_tile(p.w_proj_b, DM, DM, (bf16_t*)(ws + WS_WB), (size_t)64 * nb, nullptr, scr, 64 * kb, 64 * nb, lane); continue; } r -= I_SQ;
        if (r < I_SQ) { const int kb = r / 32, nb = r % 32; transpose_tile(p.w_out, DM, DM, (bf16_t*)(ws + WS_WO), (size_t)64 * nb, nullptr, scr, 64 * kb, 64 * nb, lane); continue; } r -= I_SQ;
        if (r < I_GU) { const int kb = r / 88, nb = r % 88, n0 = 64 * nb; transpose_tile(p.w_gate, DFF, DM, (bf16_t*)(ws + WS_WGU), (size_t)((n0 >> 7) * 256 + (n0 & 127)), p.ln_ffn_g, scr, 64 * kb, n0, lane); continue; } r -= I_GU;
        if (r < I_GU) { const int kb = r / 88, nb = r % 88, n0 = 64 * nb; transpose_tile(p.w_up, DFF, DM, (bf16_t*)(ws + WS_WGU), (size_t)((n0 >> 7) * 256 + 128 + (n0 & 127)), p.ln_ffn_g, scr, 64 * kb, n0, lane); continue; } r -= I_GU;
        { const int kb = r / 32, nb = r % 32; transpose_tile(p.w_down, DM, DFF, (bf16_t*)(ws + WS_WD), (size_t)64 * nb, nullptr, scr, 64 * kb, 64 * nb, lane); }
    }
}
__device__ __forceinline__ void phase0(const Params& p, LAS unsigned char* lds) {
    const int tid = threadIdx.x, lane = tid & 63, wave = __builtin_amdgcn_readfirstlane(tid >> 6);
    const int gw = blockIdx.x * 8 + wave, NGW = gridDim.x * 8;
    LAS unsigned* scr = (LAS unsigned*)(lds + wave * 8448);
    unsigned char* ws = p.ws;
    constexpr int NT_IN = 289, I_IN = 32 * NT_IN;
    for (int it = gw; it < I_IN; it += NGW) { const int kb = it / NT_IN, nb = it % NT_IN; bf16_t* wt = (bf16_t*)(ws + WS_WIN);
        if (nb < 128)       transpose_tile(p.w_in, INW, DM, wt, (size_t)64 * nb, nullptr, scr, 64 * kb, 64 * nb, lane);
        else if (nb == 128) transpose_tile2(p.w_in, INW, DM, (bf16_t*)(ws + WS_WBA), 0, wt, 8192, nullptr, scr, 64 * kb, 64 * nb, lane);
        else if (nb < 288)  transpose_tile(p.w_in, INW, DM, wt, (size_t)64 * nb - 32, nullptr, scr, 64 * kb, 64 * nb, lane);
        else                transpose_tile2(p.w_in, INW, DM, wt, (size_t)64 * nb - 32, nullptr, 0, nullptr, scr, 64 * kb, 64 * nb, lane); }
    bf16_t* xn = (bf16_t*)(ws + WS_XN);
    for (int m = gw; m < MTOK; m += NGW) {
        const f32x4* xr = (const f32x4*)(p.x + (size_t)m * DM) + lane; const f32x4* gr = (const f32x4*)p.ln_mix_g + lane;
        f32x4 v[8]; float s = 0.f;
#pragma unroll
        for (int j = 0; j < 8; ++j) { v[j] = xr[64 * j]; s += (v[j][0] * v[j][0] + v[j][1] * v[j][1]) + (v[j][2] * v[j][2] + v[j][3] * v[j][3]); }
        const float rs = rsqrtf(wave_sum(s) * (1.0f / DM) + EPS);
        u32x2* o = (u32x2*)(xn + (size_t)m * DM) + lane;
#pragma unroll
        for (int j = 0; j < 8; ++j) { const f32x4 g = gr[64 * j]; u32x2 w; w.x = pk2(v[j][0] * rs * g[0], v[j][1] * rs * g[1]); w.y = pk2(v[j][2] * rs * g[2], v[j][3] * rs * g[3]); o[64 * j] = w; }
    }
}

__device__ __forceinline__ void conv4_rows(const bf16_t* base, int r0, int t0, const float* cw, float (&out)[4][8]) {
    float w[4][8];
#pragma unroll
    for (int i = 0; i < 4; ++i) { const f32x4 a = *(const f32x4*)(cw + i * 6144), b = *(const f32x4*)(cw + i * 6144 + 4);
        w[i][0] = a[0]; w[i][1] = a[1]; w[i][2] = a[2]; w[i][3] = a[3]; w[i][4] = b[0]; w[i][5] = b[1]; w[i][6] = b[2]; w[i][7] = b[3]; }
    float x[7][8];
#pragma unroll
    for (int i = 0; i < 7; ++i) { const int rr = r0 - 3 + i; u32x4 v = (u32x4){0u, 0u, 0u, 0u};
        if (t0 + rr >= 0) v = *(const u32x4*)(base + (ptrdiff_t)rr * LDP);
        x[i][0] = bflo(v.x); x[i][1] = bfhi(v.x); x[i][2] = bflo(v.y); x[i][3] = bfhi(v.y); x[i][4] = bflo(v.z); x[i][5] = bfhi(v.z); x[i][6] = bflo(v.w); x[i][7] = bfhi(v.w); }
#pragma unroll
    for (int r = 0; r < 4; ++r)
#pragma unroll
        for (int j = 0; j < 8; ++j) { const float y = (w[0][j] * x[r][j] + w[1][j] * x[r + 1][j]) + (w[2][j] * x[r + 2][j] + w[3][j] * x[r + 3][j]); out[r][j] = siluf_(y); }
}
constexpr int P2_GRP = 68608;
__device__ __forceinline__ void phase2(const Params& p, LAS unsigned char* lds) {
    const int tid = threadIdx.x, grp = __builtin_amdgcn_readfirstlane(tid >> 8), lane = tid & 63, wvg = __builtin_amdgcn_readfirstlane((tid >> 6) & 3); int gt = tid & 255;
    unsigned char* ws = p.ws;
    const bf16_t* proj = (const bf16_t*)(ws + WS_PROJ);
    LAS unsigned char* gl = lds + grp * P2_GRP;
    LAS float* kn = (LAS float*)gl; LAS float* qn = (LAS float*)(gl + 33792);
    LAS float* Am = (LAS float*)(gl + 33792);
    LAS float* sbeta = (LAS float*)(gl + 67584); LAS float* sgc = sbeta + 64; LAS float* srsw = sbeta + 128;
    for (int item = blockIdx.x; item < 1024; item += gridDim.x) {
        asm volatile("" : "+v"(gt));
        const int unit = item * 2 + grp;
        const int b = unit >> 9, h = (unit >> 5) & 15, n = unit & 31, t0 = n * 64;
        const bf16_t* prow = proj + ((size_t)b * SEQ + t0) * LDP;
        unsigned char* hand = ws + WS_HAND + (size_t)unit * HAND_UNIT;
        bf16_t* w_g = (bf16_t*)hand; bf16_t* qd_g = (bf16_t*)(hand + 16384); bf16_t* kdT_g = (bf16_t*)(hand + 32768); bf16_t* uT_g = (bf16_t*)(hand + 49152); bf16_t* at_g = (bf16_t*)(hand + 65536);
        if (wvg == 0) {
            const float* bap = (const float*)(ws + WS_BA) + ((size_t)b * SEQ + t0 + gt) * 32; const float bb = bap[h], aa = bap[16 + h];
            const float xs = aa + p.dt_bias[h]; const float sp = xs > 20.f ? xs : __logf(1.0f + __expf(xs));
            float g = -__expf(p.A_log[h]) * sp;
#pragma unroll
            for (int o = 1; o < 64; o <<= 1) { const float t = __shfl_up(g, o); if (lane >= o) g += t; }
            sbeta[gt] = sigmoidf_(bb); sgc[gt] = g;
            if (gt == 63) ((float*)(ws + WS_EGL))[unit] = __expf(g);
        }
        const int r0 = (gt >> 4) * 4, c0 = (gt & 15) * 8;
        float qv[4][8], kv[4][8]; float rnk[4];
        conv4_rows(prow + OFF_Q + h * 128 + c0, r0, t0, p.conv_qkv_w + OFF_Q + h * 128 + c0, qv);
        conv4_rows(prow + OFF_K + h * 128 + c0, r0, t0, p.conv_qkv_w + OFF_K + h * 128 + c0, kv);
#pragma unroll
        for (int r = 0; r < 4; ++r) { float sq = 0.f, sk = 0.f;
#pragma unroll
            for (int j = 0; j < 8; ++j) { sq += qv[r][j] * qv[r][j]; sk += kv[r][j] * kv[r][j]; }
#pragma unroll
            for (int o = 1; o < 16; o <<= 1) { sq += __shfl_xor(sq, o); sk += __shfl_xor(sk, o); }
            const float rq = rsqrtf(sq + EPS) * 0.08838834764831845f; rnk[r] = rsqrtf(sk + EPS);
#pragma unroll
            for (int j = 0; j < 8; ++j) { qv[r][j] *= rq; kv[r][j] *= rnk[r]; } }
        LDS_BARRIER();
        const float gcl = sgc[63];
        float ekl[4];
#pragma unroll
        for (int r = 0; r < 4; ++r) { const int row = r0 + r; const float gc = sgc[row], eg = __expf(gc); ekl[r] = __expf(gcl - gc);
            u32x4 wd;
            *(LAS f32x4*)(qn + row * 132 + c0) = (f32x4){qv[r][0], qv[r][1], qv[r][2], qv[r][3]}; *(LAS f32x4*)(qn + row * 132 + c0 + 4) = (f32x4){qv[r][4], qv[r][5], qv[r][6], qv[r][7]};
            *(LAS f32x4*)(kn + row * 132 + c0) = (f32x4){kv[r][0], kv[r][1], kv[r][2], kv[r][3]}; *(LAS f32x4*)(kn + row * 132 + c0 + 4) = (f32x4){kv[r][4], kv[r][5], kv[r][6], kv[r][7]};
            wd.x = pk2x<1>(qv[r][0] * eg, qv[r][1] * eg); wd.y = pk2x<1>(qv[r][2] * eg, qv[r][3] * eg); wd.z = pk2x<1>(qv[r][4] * eg, qv[r][5] * eg); wd.w = pk2x<1>(qv[r][6] * eg, qv[r][7] * eg);
            *(u32x4*)(qd_g + row * 128 + c0) = wd;
            if ((gt & 15) == 0) srsw[row] = rnk[r] * sbeta[row] * eg; }
#pragma unroll
        for (int j = 0; j < 8; ++j) { u32x2 w; w.x = pk2x<1>(kv[0][j] * ekl[0], kv[1][j] * ekl[1]); w.y = pk2x<1>(kv[2][j] * ekl[2], kv[3][j] * ekl[3]); *(u32x2*)(kdT_g + (c0 + j) * 64 + r0) = w; }
        LDS_BARRIER();
        {
            const int wv = wvg, lr = lane & 15, lq = lane >> 4;
            f32x4 aK[4], aQ[4];
#pragma unroll
            for (int jb = 0; jb < 4; ++jb) { aK[jb] = (f32x4){0.f, 0.f, 0.f, 0.f}; aQ[jb] = (f32x4){0.f, 0.f, 0.f, 0.f}; }
#pragma unroll 2
            for (int kk = 0; kk < 8; ++kk) {
                const f32x4 ka = *(const LAS f32x4*)(kn + (16 * wv + lr) * 132 + 16 * kk + 4 * lq), qa = *(const LAS f32x4*)(qn + (16 * wv + lr) * 132 + 16 * kk + 4 * lq);
#pragma unroll
                for (int jb = 0; jb < 4; ++jb) if (jb <= wv) {
                    const f32x4 kb = *(const LAS f32x4*)(kn + (16 * jb + lr) * 132 + 16 * kk + 4 * lq);
#pragma unroll
                    for (int e = 0; e < 4; ++e) { aK[jb] = __builtin_amdgcn_mfma_f32_16x16x4f32(ka[e], kb[e], aK[jb], 0, 0, 0); aQ[jb] = __builtin_amdgcn_mfma_f32_16x16x4f32(qa[e], kb[e], aQ[jb], 0, 0, 0); }
                }
            }
            LDS_BARRIER();
#pragma unroll
            for (int jb = 0; jb < 4; ++jb) {
                const int j = 16 * jb + lr; const float gcj = sgc[j];
#pragma unroll
                for (int r = 0; r < 4; ++r) { const int i = 16 * wv + 4 * lq + r;
                    const float dec = (i >= j) ? __expf(sgc[i] - gcj) : 0.f;
                    Am[i * 64 + j] = (i > j) ? sbeta[i] * aK[jb][r] * dec : 0.f;
                    at_g[i * 64 + j] = (bf16_t)(pk2x<1>(aQ[jb][r] * dec, 0.f) & 0xffffu); }
            }
        }
        float X[64];
        {
            const bool isv = wvg < 2; const int cc = gt & 127;
            const int col = (isv ? OFF_V : OFF_K) + h * 128 + cc;
            const float* cwp = p.conv_qkv_w + col;
            const float w0 = cwp[0], w1 = cwp[6144], w2 = cwp[2 * 6144], w3 = cwp[3 * 6144];
            const LAS float* scl = isv ? sbeta : srsw;
            const bf16_t* pc = prow + col;
            float x0 = 0.f, x1 = 0.f, x2 = 0.f;
            if (t0 > 0) { x0 = bf2f(pc[-3 * (ptrdiff_t)LDP]); x1 = bf2f(pc[-2 * (ptrdiff_t)LDP]); x2 = bf2f(pc[-(ptrdiff_t)LDP]); }
#pragma unroll
            for (int i = 0; i < 64; ++i) { const float x3 = bf2f(pc[(size_t)i * LDP]); const float y = (w0 * x0 + w1 * x1) + (w2 * x2 + w3 * x3); X[i] = siluf_(y) * scl[i]; x0 = x1; x1 = x2; x2 = x3; }
        }
        LDS_BARRIER();
#pragma unroll
        for (int i = 1; i < 64; ++i) {
            float xa = X[i], xb = 0.f;
#pragma unroll
            for (int j4 = 0; j4 < (i + 3) / 4; ++j4) {
                const f32x4 a = *(const LAS f32x4*)(Am + i * 64 + 4 * j4);
                if (j4 & 1) { xb -= a[0] * X[4 * j4]; xb -= a[1] * X[4 * j4 + 1]; xb -= a[2] * X[4 * j4 + 2]; xb -= a[3] * X[4 * j4 + 3]; }
                else        { xa -= a[0] * X[4 * j4]; xa -= a[1] * X[4 * j4 + 1]; xa -= a[2] * X[4 * j4 + 2]; xa -= a[3] * X[4 * j4 + 3]; }
            }
            X[i] = xa + xb;
        }
        if (wvg < 2) {
#pragma unroll
            for (int i8 = 0; i8 < 8; ++i8) { u32x4 w; w.x = pk2x<1>(X[8 * i8], X[8 * i8 + 1]); w.y = pk2x<1>(X[8 * i8 + 2], X[8 * i8 + 3]); w.z = pk2x<1>(X[8 * i8 + 4], X[8 * i8 + 5]); w.w = pk2x<1>(X[8 * i8 + 6], X[8 * i8 + 7]);
                *(u32x4*)(uT_g + (gt & 127) * 64 + 8 * i8) = w; }
        } else {
#pragma unroll
            for (int i = 0; i < 64; ++i) w_g[i * 128 + (gt & 127)] = (bf16_t)(pk2x<1>(X[i], 0.f) & 0xffffu);
        }
    }
}
__device__ __forceinline__ void phase2_mixer(const Params& p, int first, int stride) {
    const int tid = threadIdx.x; unsigned char* ws = p.ws;
    {
        bf16_t* projw = (bf16_t*)(ws + WS_PROJ);
        for (int item = first; item < 512; item += stride) {
            const int idx = item * 512 + tid; const int c0 = (idx & 255) * 8, r8 = (idx >> 8) * 8; const int t = r8 & (SEQ - 1);
            float w[3][8];
#pragma unroll
            for (int i = 0; i < 3; ++i) { const f32x4 a = *(const f32x4*)(p.conv_sc_w + i * 2048 + c0), bq = *(const f32x4*)(p.conv_sc_w + i * 2048 + c0 + 4);
                w[i][0] = a[0]; w[i][1] = a[1]; w[i][2] = a[2]; w[i][3] = a[3]; w[i][4] = bq[0]; w[i][5] = bq[1]; w[i][6] = bq[2]; w[i][7] = bq[3]; }
            float p0[8], p1[8];
#pragma unroll
            for (int j = 0; j < 8; ++j) { p0[j] = 0.f; p1[j] = 0.f; }
            if (t > 0) {
                const bf16_t* ra = projw + (size_t)(r8 - 2) * LDP; const bf16_t* rb = projw + (size_t)(r8 - 1) * LDP;
                const u32x4 ca = *(const u32x4*)(ra + OFF_SC + c0), ha = *(const u32x4*)(ra + OFF_SH + c0), cb = *(const u32x4*)(rb + OFF_SC + c0), hb = *(const u32x4*)(rb + OFF_SH + c0);
                p0[0] = bflo(ca.x) * bflo(ha.x); p0[1] = bfhi(ca.x) * bfhi(ha.x); p0[2] = bflo(ca.y) * bflo(ha.y); p0[3] = bfhi(ca.y) * bfhi(ha.y);
                p0[4] = bflo(ca.z) * bflo(ha.z); p0[5] = bfhi(ca.z) * bfhi(ha.z); p0[6] = bflo(ca.w) * bflo(ha.w); p0[7] = bfhi(ca.w) * bfhi(ha.w);
                p1[0] = bflo(cb.x) * bflo(hb.x); p1[1] = bfhi(cb.x) * bfhi(hb.x); p1[2] = bflo(cb.y) * bflo(hb.y); p1[3] = bfhi(cb.y) * bfhi(hb.y);
                p1[4] = bflo(cb.z) * bflo(hb.z); p1[5] = bfhi(cb.z) * bfhi(hb.z); p1[6] = bflo(cb.w) * bflo(hb.w); p1[7] = bfhi(cb.w) * bfhi(hb.w);
            }
#pragma unroll
            for (int i = 0; i < 8; ++i) {
                bf16_t* rp = projw + (size_t)(r8 + i) * LDP;
                const u32x4 cv = *(const u32x4*)(rp + OFF_SC + c0), hv = *(const u32x4*)(rp + OFF_SH + c0), bv = *(const u32x4*)(rp + OFF_SB + c0);
                float p2[8], bb[8], o[8];
                p2[0] = bflo(cv.x) * bflo(hv.x); p2[1] = bfhi(cv.x) * bfhi(hv.x); p2[2] = bflo(cv.y) * bflo(hv.y); p2[3] = bfhi(cv.y) * bfhi(hv.y);
                p2[4] = bflo(cv.z) * bflo(hv.z); p2[5] = bfhi(cv.z) * bfhi(hv.z); p2[6] = bflo(cv.w) * bflo(hv.w); p2[7] = bfhi(cv.w) * bfhi(hv.w);
                bb[0] = bflo(bv.x); bb[1] = bfhi(bv.x); bb[2] = bflo(bv.y); bb[3] = bfhi(bv.y); bb[4] = bflo(bv.z); bb[5] = bfhi(bv.z); bb[6] = bflo(bv.w); bb[7] = bfhi(bv.w);
#pragma unroll
                for (int j = 0; j < 8; ++j) { o[j] = bb[j] * (w[0][j] * p0[j] + w[1][j] * p1[j] + w[2][j] * p2[j]); p0[j] = p1[j]; p1[j] = p2[j]; }
                u32x4 wv; wv.x = pk2x<3>(o[0], o[1]); wv.y = pk2x<3>(o[2], o[3]); wv.z = pk2x<3>(o[4], o[5]); wv.w = pk2x<3>(o[6], o[7]);
                *(u32x4*)(rp + OFF_SB + c0) = wv;
            }
        }
    }
}

__device__ __forceinline__ void phase3(const Params& p, LAS unsigned char* lds, bf16_t* oa_base, int oa_ld) {
    const int tid = threadIdx.x, l = tid & 63, wv = __builtin_amdgcn_readfirstlane(tid >> 6), lr = l & 15, lq = l >> 4, tb = wv & 3, vh = wv >> 2, db = wv;
    unsigned char* ws = p.ws;
    LAS bf16_t* ST = (LAS bf16_t*)lds;
    LAS bf16_t* vT = (LAS bf16_t*)(lds + 34816);
    LAS float* oL = (LAS float*)(lds + 53248);
    LAS float* ngL = (LAS float*)(lds + 87040);
    const int prw = tid >> 3, pcs = (tid & 7) * 16;
    for (int bh = blockIdx.x; bh < 64; bh += gridDim.x) {
        const int b = bh >> 4, h = bh & 15;
        __syncthreads();
        for (int i = tid; i < 34816 / 16; i += 512) ((LAS u32x4*)ST)[i] = (u32x4){0u, 0u, 0u, 0u};
        if (tid < 128) ngL[tid] = p.gdn_norm_g[tid];
        f32x4 accS[8];
#pragma unroll
        for (int v = 0; v < 8; ++v) accS[v] = (f32x4){0.f, 0.f, 0.f, 0.f};
        __syncthreads();
        const unsigned char* hand0 = ws + WS_HAND + (size_t)bh * 32 * HAND_UNIT;
        const float* egl_g = (const float*)(ws + WS_EGL) + bh * 32;
        const bf16_t* projz = (const bf16_t*)(ws + WS_PROJ); const unsigned zoff = (unsigned)((b * SEQ + prw) * LDP + OFF_Z + h * 128 + pcs);
        const unsigned ooff = (unsigned)((b * SEQ + prw) * oa_ld + h * 128 + pcs);
        const int o_wq = (16 * tb + lr) * 128 + 8 * lq, o_at = (16 * tb + lr) * 64 + 8 * lq, o_k = (16 * db + lr) * 64 + 8 * lq, o_u = (64 * vh + lr) * 64 + 16 * tb + 4 * lq;
        bf16x8 c_w[4], c_q[4], c_at[2], c_k[2], n_at[2], n_k[2]; u32x2 c_u[4]; u32x4 c_z[2]; float c_e, n_e;
#define P3_LOAD_A(nn) do { const bf16_t* hb_ = (const bf16_t*)(hand0 + (size_t)(nn) * HAND_UNIT); \
        _Pragma("unroll") for (int ks = 0; ks < 4; ++ks) { c_w[ks] = *(const bf16x8*)(hb_ + o_wq + 32 * ks); c_q[ks] = *(const bf16x8*)(hb_ + 8192 + o_wq + 32 * ks); } \
        _Pragma("unroll") for (int j = 0; j < 4; ++j) c_u[j] = *(const u32x2*)(hb_ + 24576 + o_u + 1024 * j); } while (0)
#define P3_LOAD_B(AT_, K_, E_, nn) do { const bf16_t* hb_ = (const bf16_t*)(hand0 + (size_t)(nn) * HAND_UNIT); \
        _Pragma("unroll") for (int ks = 0; ks < 2; ++ks) { AT_[ks] = *(const bf16x8*)(hb_ + 32768 + o_at + 32 * ks); K_[ks] = *(const bf16x8*)(hb_ + 16384 + o_k + 32 * ks); } \
        E_ = egl_g[nn]; } while (0)
#define P3_LOAD_Z(nn) do { const bf16_t* zp_ = projz + (zoff + (unsigned)(nn) * (64u * LDP)); c_z[0] = *(const u32x4*)zp_; c_z[1] = *(const u32x4*)(zp_ + 8); } while (0)
        P3_LOAD_A(0); P3_LOAD_B(c_at, c_k, c_e, 0); P3_LOAD_Z(0);
#define P3_PHASE_C(nc) do { \
            float o[16]; float ss = 0.f; \
            _Pragma("unroll") for (int q4 = 0; q4 < 4; ++q4) { const f32x4 t = *(const LAS f32x4*)(oL + prw * 132 + pcs + 4 * q4); o[4 * q4] = t[0]; o[4 * q4 + 1] = t[1]; o[4 * q4 + 2] = t[2]; o[4 * q4 + 3] = t[3]; \
                ss += (t[0] * t[0] + t[1] * t[1]) + (t[2] * t[2] + t[3] * t[3]); } \
            ss += __shfl_xor(ss, 1); ss += __shfl_xor(ss, 2); ss += __shfl_xor(ss, 4); \
            const float rs = rsqrtf(ss * (1.0f / 128.0f) + EPS); \
            float zf[16]; \
            zf[0] = bflo(c_z[0].x); zf[1] = bfhi(c_z[0].x); zf[2] = bflo(c_z[0].y); zf[3] = bfhi(c_z[0].y); zf[4] = bflo(c_z[0].z); zf[5] = bfhi(c_z[0].z); zf[6] = bflo(c_z[0].w); zf[7] = bfhi(c_z[0].w); \
            zf[8] = bflo(c_z[1].x); zf[9] = bfhi(c_z[1].x); zf[10] = bflo(c_z[1].y); zf[11] = bfhi(c_z[1].y); zf[12] = bflo(c_z[1].z); zf[13] = bfhi(c_z[1].z); zf[14] = bflo(c_z[1].w); zf[15] = bfhi(c_z[1].w); \
            _Pragma("unroll") for (int q4 = 0; q4 < 4; ++q4) { const f32x4 g = *(const LAS f32x4*)(ngL + pcs + 4 * q4); \
                _Pragma("unroll") for (int j = 0; j < 4; ++j) o[4 * q4 + j] = o[4 * q4 + j] * rs * g[j] * siluf_(zf[4 * q4 + j]); } \
            u32x4 w0, w1; \
            w0.x = pk2x<3>(o[0], o[1]); w0.y = pk2x<3>(o[2], o[3]); w0.z = pk2x<3>(o[4], o[5]); w0.w = pk2x<3>(o[6], o[7]); \
            w1.x = pk2x<3>(o[8], o[9]); w1.y = pk2x<3>(o[10], o[11]); w1.z = pk2x<3>(o[12], o[13]); w1.w = pk2x<3>(o[14], o[15]); \
            bf16_t* zp = oa_base + (ooff + (unsigned)(nc) * (64u * (unsigned)oa_ld)); *(u32x4*)zp = w0; *(u32x4*)(zp + 8) = w1; } while (0)
#define P3_STEP(n, WITH_C) do { \
            const int nn = (n) < 31 ? (n) + 1 : 31; \
            P3_LOAD_B(n_at, n_k, n_e, nn); \
            f32x4 accV[4], accO[4]; \
            _Pragma("unroll") for (int j = 0; j < 4; ++j) { accV[j] = (f32x4){0.f, 0.f, 0.f, 0.f}; accO[j] = (f32x4){0.f, 0.f, 0.f, 0.f}; } \
            _Pragma("unroll") for (int kh = 0; kh < 2; ++kh) { bf16x8 SB[4][2]; \
              _Pragma("unroll") for (int j = 0; j < 4; ++j) _Pragma("unroll") for (int k2 = 0; k2 < 2; ++k2) SB[j][k2] = *(const LAS bf16x8*)(ST + (16 * (4 * vh + j) + lr) * 136 + 32 * (2 * kh + k2) + 8 * lq); \
              _Pragma("unroll") for (int k2 = 0; k2 < 2; ++k2) _Pragma("unroll") for (int j = 0; j < 4; ++j) { accV[j] = MFMA16(c_w[2 * kh + k2], SB[j][k2], accV[j]); accO[j] = MFMA16(c_q[2 * kh + k2], SB[j][k2], accO[j]); } } \
            if (WITH_C) { P3_PHASE_C((n) - 1); P3_LOAD_Z(n); } \
            _Pragma("unroll") for (int j = 0; j < 4; ++j) { const int vb = 4 * vh + j; \
                const float v0 = bflo(c_u[j].x) - accV[j][0], v1 = bfhi(c_u[j].x) - accV[j][1], v2 = bflo(c_u[j].y) - accV[j][2], v3 = bfhi(c_u[j].y) - accV[j][3]; \
                u32x2 w; w.x = pk2x<2>(v0, v1); w.y = pk2x<2>(v2, v3); \
                *(LAS u32x2*)(vT + (16 * vb + lr) * 72 + 16 * tb + 4 * lq) = w; } \
            P3_LOAD_A(nn); \
            LDS_BARRIER(); \
            { bf16x8 VB[8][2]; \
              _Pragma("unroll") for (int vb = 0; vb < 8; ++vb) _Pragma("unroll") for (int ks = 0; ks < 2; ++ks) VB[vb][ks] = *(const LAS bf16x8*)(vT + (16 * vb + lr) * 72 + 32 * ks + 8 * lq); \
              _Pragma("unroll") for (int ks = 0; ks < 2; ++ks) if (ks == 0 || tb >= 2) { \
                  _Pragma("unroll") for (int j = 0; j < 4; ++j) accO[j] = MFMA16(c_at[ks], vh ? VB[4 + j][ks] : VB[j][ks], accO[j]); } \
              _Pragma("unroll") for (int vb = 0; vb < 8; ++vb) accS[vb] = accS[vb] * c_e; \
              _Pragma("unroll") for (int ks = 0; ks < 2; ++ks) _Pragma("unroll") for (int vb = 0; vb < 8; ++vb) accS[vb] = MFMA16(c_k[ks], VB[vb][ks], accS[vb]); } \
            _Pragma("unroll") for (int j = 0; j < 4; ++j) { const int vb = 4 * vh + j; \
                _Pragma("unroll") for (int r = 0; r < 4; ++r) oL[(16 * tb + 4 * lq + r) * 132 + 16 * vb + lr] = accO[j][r]; } \
            _Pragma("unroll") for (int vb = 0; vb < 8; ++vb) { u32x2 w; w.x = pk2x<2>(accS[vb][0], accS[vb][1]); w.y = pk2x<2>(accS[vb][2], accS[vb][3]); \
                *(LAS u32x2*)(ST + (16 * vb + lr) * 136 + 16 * db + 4 * lq) = w; } \
            LDS_BARRIER(); \
            c_at[0] = n_at[0]; c_at[1] = n_at[1]; c_k[0] = n_k[0]; c_k[1] = n_k[1]; c_e = n_e; } while (0)
        P3_STEP(0, false);
        for (int n = 1; n < 32; ++n) P3_STEP(n, true);
        P3_PHASE_C(31);
#undef P3_STEP
#undef P3_PHASE_C
#undef P3_LOAD_A
#undef P3_LOAD_B
#undef P3_LOAD_Z
    }
}

__device__ __forceinline__ void phase8(const Params& p) {
    const int tid = threadIdx.x, lane = tid & 63, wave = __builtin_amdgcn_readfirstlane(tid >> 6);
    const int gw = blockIdx.x * 8 + wave, NGW = gridDim.x * 8;
    for (int m = gw; m < MTOK; m += NGW) {
        f32x4* xr = (f32x4*)(p.out + (size_t)m * DM) + lane; const f32x4* gr = (const f32x4*)p.ln_final_g + lane;
        f32x4 v[8]; float s = 0.f;
#pragma unroll
        for (int j = 0; j < 8; ++j) { v[j] = xr[64 * j]; s += (v[j][0] * v[j][0] + v[j][1] * v[j][1]) + (v[j][2] * v[j][2] + v[j][3] * v[j][3]); }
        const float rs = rsqrtf(wave_sum(s) * (1.0f / DM) + EPS);
#pragma unroll
        for (int j = 0; j < 8; ++j) { const f32x4 g = gr[64 * j]; xr[64 * j] = v[j] * rs * g; }
    }
}

#define XB_TMO      128
#define XB_XCNT(j)  (256  + 64 * (j))
#define XB_XSUB(j)  (1280 + 64 * (j))
#define XB_XGEN(j)  (2304 + 64 * (j))
#define XB_TOP      3328
#define XB_TOPGEN   3392
#define XCD_BAR_WORDS 3456
#define XB_SPIN_CAP (1u << 18)
__device__ __forceinline__ unsigned xb_ld(unsigned* p)              { return __hip_atomic_load(p, __ATOMIC_RELAXED, __HIP_MEMORY_SCOPE_AGENT); }
__device__ __forceinline__ unsigned xb_add(unsigned* p, unsigned v) { return __hip_atomic_fetch_add(p, v, __ATOMIC_RELAXED, __HIP_MEMORY_SCOPE_AGENT); }
__device__ __forceinline__ unsigned xb_xcc_id() { return (unsigned)__builtin_amdgcn_s_getreg((3 << 11) | 20) & 0xFu; }
#define XB_SPIN(cond, bar) do { unsigned _sp = 0; while (cond) { __builtin_amdgcn_s_sleep(1); \
    if ((++_sp & 255u) == 0u) { if (xb_ld(&(bar)[XB_TMO])) break; if (_sp > XB_SPIN_CAP) { atomicAdd(&(bar)[XB_TMO], 1u); break; } } } } while (0)

struct XcdBarrier {
    unsigned* bar; unsigned x;
    volatile LAS unsigned* st;
};

__device__ __forceinline__ XcdBarrier xcd_barrier_post(unsigned* bar, volatile LAS unsigned* st) {
    XcdBarrier b; b.bar = bar; b.x = xb_xcc_id(); b.st = st;
    if (threadIdx.x == 0) (void)xb_add(&bar[XB_XCNT(b.x)], 1u);
    return b;
}
__device__ __forceinline__ void xcd_barrier_complete(unsigned* bar, unsigned x, unsigned& nloc, unsigned& nx) {
    const unsigned G = gridDim.x * gridDim.y * gridDim.z;
    unsigned sum, cnt, mine, sp = 0u;
    for (;;) {
        sum = 0u; cnt = 0u; mine = 0u;
#pragma unroll
        for (unsigned j = 0; j < 16; ++j) { const unsigned c = xb_ld(&bar[XB_XCNT(j)]); sum += c; cnt += (c > 0u) ? 1u : 0u; mine = (j == x) ? c : mine; }
        if (sum == G) break;
        __builtin_amdgcn_s_sleep(1);
        if ((++sp & 255u) == 0u) { if (xb_ld(&bar[XB_TMO])) break; if (sp > XB_SPIN_CAP) { atomicAdd(&bar[XB_TMO], 1u); break; } }
    }
    nloc = mine > 0u ? mine : 1u; nx = cnt > 0u ? cnt : 1u;
}

__device__ __forceinline__ void xcd_barrier(const XcdBarrier& b) {
    asm volatile("s_waitcnt vmcnt(0)" ::: "memory");
    __syncthreads();
    if (threadIdx.x == 0) {
        unsigned* bar = b.bar;
        __builtin_amdgcn_s_waitcnt(0);
        unsigned nloc = b.st[0], nx = b.st[1];
        if (nloc == 0u) { xcd_barrier_complete(bar, b.x, nloc, nx); b.st[0] = nloc; b.st[1] = nx; }
        const unsigned old = xb_add(&bar[XB_XSUB(b.x)], 1u);
        const unsigned gen = old / nloc;
        if (old + 1u == (gen + 1u) * nloc) {
            __builtin_amdgcn_fence(__ATOMIC_RELEASE, "agent");
            asm volatile("s_waitcnt vmcnt(0)" ::: "memory");
            const unsigned og = xb_add(&bar[XB_TOP], 1u);
            const unsigned tg = og / nx;
            if (og + 1u == (tg + 1u) * nx) xb_add(&bar[XB_TOPGEN], 1u);
            else XB_SPIN(xb_ld(&bar[XB_TOPGEN]) == tg, bar);
            __builtin_amdgcn_fence(__ATOMIC_ACQUIRE, "agent");
            xb_add(&bar[XB_XGEN(b.x)], 1u);
            asm volatile("s_waitcnt vmcnt(0)" ::: "memory");
        } else {
            XB_SPIN(xb_ld(&bar[XB_XGEN(b.x)]) == gen, bar);
            __builtin_amdgcn_fence(__ATOMIC_ACQUIRE, "agent");
            asm volatile("s_waitcnt vmcnt(0)" ::: "memory");
        }
    }
    __syncthreads();
}

__device__ __forceinline__ void side_gemm_ba(const Params& p, LAS unsigned char* lds) {
    const int tid = threadIdx.x, l = tid & 63, w = __builtin_amdgcn_readfirstlane(tid >> 6), lr = l & 15, lq = l >> 4;
    const bf16_t* xn = (const bf16_t*)(p.ws + WS_XN); const bf16_t* wba = (const bf16_t*)(p.ws + WS_WBA); float* ba = (float*)(p.ws + WS_BA);
    LAS f32x4* red = (LAS f32x4*)lds;
    for (int rb = blockIdx.x; rb < MTOK / 32; rb += gridDim.x) {
        f32x4 acc[2][2];
#pragma unroll
        for (int i = 0; i < 2; ++i)
#pragma unroll
            for (int j = 0; j < 2; ++j) acc[i][j] = (f32x4){0.f, 0.f, 0.f, 0.f};
#pragma unroll 2
        for (int ks = 0; ks < 8; ++ks) {
            bf16x8 af[2], bfr[2];
#pragma unroll
            for (int i = 0; i < 2; ++i) { af[i] = *(const bf16x8*)(xn + (size_t)(32 * rb + 16 * i + lr) * DM + 256 * w + 32 * ks + 8 * lq); bfr[i] = *(const bf16x8*)(wba + (size_t)(16 * i + lr) * DM + 256 * w + 32 * ks + 8 * lq); }
#pragma unroll
            for (int i = 0; i < 2; ++i)
#pragma unroll
                for (int j = 0; j < 2; ++j) acc[i][j] = MFMA16(af[i], bfr[j], acc[i][j]);
        }
        __syncthreads();
#pragma unroll
        for (int i = 0; i < 2; ++i)
#pragma unroll
            for (int j = 0; j < 2; ++j) red[(w * 4 + i * 2 + j) * 64 + l] = acc[i][j];
        __syncthreads();
        if (w < 4) { const int ti = w >> 1, tj = w & 1; f32x4 sacc = (f32x4){0.f, 0.f, 0.f, 0.f};
#pragma unroll
            for (int ww = 0; ww < 8; ++ww) sacc = sacc + red[(ww * 4 + w) * 64 + l];
#pragma unroll
            for (int r = 0; r < 4; ++r) ba[(size_t)(32 * rb + 16 * ti + 4 * lq + r) * 32 + 16 * tj + lr] = sacc[r]; }
    }
    __syncthreads();
}

__global__ void __launch_bounds__(512, 2) hybrid_fwd(Params p) {
    extern __shared__ __attribute__((aligned(16))) unsigned char smem[];
    LAS unsigned char* lds = (LAS unsigned char*)smem;
    cg::grid_group grid = cg::this_grid();
    unsigned char* ws = p.ws;
    const int lo = p.ph_lo, hi = p.ph_hi, G = gridDim.x, c = blockIdx.x;
#define IN(k) (lo <= (k) && (k) < hi)
    volatile LAS unsigned* xst = (volatile LAS unsigned*)(lds + 147440);
    if (threadIdx.x == 0) { xst[0] = 0u; xst[1] = 0u; }
    __syncthreads();
    XcdBarrier xb; xb.bar = (unsigned*)(ws + WS_BAR); xb.x = 0; xb.st = xst;
    if (hi - lo > 1) xb = xcd_barrier_post((unsigned*)(ws + WS_BAR), xst);
    if (hi - lo > 1) grid.sync();
#define SEAM(k) do { if (IN(k) && IN((k) + 1)) xcd_barrier(xb); } while (0)
#ifndef DUP_MASK
#define DUP_MASK 0
#endif
#define NREP(k) (((DUP_MASK >> (k)) & 1) ? 2 : 1)
    if (IN(0)) for (int rep = 0; rep < NREP(0); ++rep) { phase0(p, lds); __syncthreads(); }
    SEAM(0);
#ifdef EXTRA_SYNCS
    for (int e = 0; e < EXTRA_SYNCS; ++e) grid.sync();
#endif
    if (IN(1)) for (int rep = 0; rep < NREP(1); ++rep) { side_gemm_ba(p, lds); pg8::Gemm g{(const bf16_t*)(ws + WS_XN), (const bf16_t*)(ws + WS_WIN), MTOK, LDP, DM, DM}; pg8::StaticOrder S; S.init(MTOK, LDP, G, c);
        EpiProj E{(bf16_t*)(ws + WS_PROJ), LDP}; pg8::gemm_phase<EpiProj, pg8::StaticOrder>(lds, g, S, E, nullptr); }
    SEAM(1);
    if (IN(2)) { for (int rep = 0; rep < NREP(2); ++rep) { phase2(p, lds); __syncthreads(); } if (!(IN(3) && G > 64)) phase2_mixer(p, c, G); }
    SEAM(2);
    if (IN(3)) { if (NREP(3) == 2) { phase3(p, lds, (bf16_t*)p.out, DM); __syncthreads(); } phase3(p, lds, (bf16_t*)(ws + WS_PROJ) + OFF_Z, LDP);
        if (G > 64) { if (c >= 64) { convert_late_weights(p, lds, (c - 64) * 8 + (int)(threadIdx.x >> 6), (G - 64) * 8); if (IN(2)) phase2_mixer(p, c - 64, G - 64); } }
        else { __syncthreads(); convert_late_weights(p, lds, c * 8 + (int)(threadIdx.x >> 6), G * 8); } }
    SEAM(3);
    if (IN(4)) {
        { pg8::Gemm g{(const bf16_t*)(ws + WS_PROJ) + OFF_Z, (const bf16_t*)(ws + WS_WA), MTOK, DM, DM, LDP}; pg8::StaticOrder S; S.init(MTOK, DM, G, c);
          EpiMergeA E{(float*)(ws + WS_MA), (const bf16_t*)(ws + WS_PROJ)}; pg8::gemm_phase<EpiMergeA, pg8::StaticOrder>(lds, g, S, E, nullptr); }
        __syncthreads();
        { pg8::Gemm g{(const bf16_t*)(ws + WS_PROJ) + OFF_SB, (const bf16_t*)(ws + WS_WB), MTOK, DM, DM, LDP}; pg8::StaticOrder S; S.init(MTOK, DM, G, c);
          EpiMergeB E{(const float*)(ws + WS_MA), (bf16_t*)(ws + WS_MB), (const bf16_t*)(ws + WS_PROJ)}; pg8::gemm_phase<EpiMergeB, pg8::StaticOrder>(lds, g, S, E, nullptr); }
    }
    SEAM(4);
    if (IN(5)) { pg8::Gemm g{(const bf16_t*)(ws + WS_MB), (const bf16_t*)(ws + WS_WO), MTOK, DM, DM, DM}; pg8::StaticOrder S; S.init(MTOK, DM, G, c);
        EpiResid E{p.x, (float*)(ws + WS_H1F), (bf16_t*)(ws + WS_H1B), (float*)(ws + WS_RSQ1)}; pg8::gemm_phase<EpiResid, pg8::StaticOrder>(lds, g, S, E, nullptr); }
    SEAM(5);
    if (IN(6)) { pg8::Gemm g{(const bf16_t*)(ws + WS_H1B), (const bf16_t*)(ws + WS_WGU), MTOK, 2 * DFF, DM, DM}; pg8::StaticOrder S; S.init(MTOK, 2 * DFF, G, c);
        EpiFFN E{(bf16_t*)(ws + WS_FF), (const float*)(ws + WS_RSQ1)}; pg8::gemm_phase<EpiFFN, pg8::StaticOrder>(lds, g, S, E, nullptr); }
    SEAM(6);
    if (IN(7)) { pg8::Gemm g{(const bf16_t*)(ws + WS_FF), (const bf16_t*)(ws + WS_WD), MTOK, DM, DFF, DFF}; pg8::StaticOrder S; S.init(MTOK, DM, G, c);
        EpiResid E{(const float*)(ws + WS_H1F), p.out, nullptr, nullptr}; pg8::gemm_phase<EpiResid, pg8::StaticOrder>(lds, g, S, E, nullptr); }
    SEAM(7);
    if (IN(8)) phase8(p);
#undef IN
#undef SEAM
}

extern "C" void kernel_launch(void* const* d_in, const int* in_sizes, int n_in, void* d_out, int out_size, void* d_ws, size_t ws_size, hipStream_t stream) {
    constexpr int LDS_BYTES = 147456;
    static int grid = 0;
    if (grid == 0) {
        if (n_in != 16 || out_size != MTOK * DM || ws_size < WS_END) { fprintf(stderr, "kernel_launch: unexpected shapes (n_in %d out %d ws %zu need %zu)\n", n_in, out_size, ws_size, (size_t)WS_END); grid = -1; return; }
        int dev = 0, cus = 0, per_cu = 0;
        hipGetDevice(&dev); hipDeviceGetAttribute(&cus, hipDeviceAttributeMultiprocessorCount, dev);
        if (hipFuncSetAttribute((const void*)hybrid_fwd, hipFuncAttributeMaxDynamicSharedMemorySize, LDS_BYTES) != hipSuccess) { fprintf(stderr, "kernel_launch: hipFuncSetAttribute failed\n"); grid = -1; return; }
        if (hipOccupancyMaxActiveBlocksPerMultiprocessor(&per_cu, (const void*)hybrid_fwd, 512, LDS_BYTES) != hipSuccess || per_cu < 1) { fprintf(stderr, "kernel_launch: occupancy query says %d blocks per CU\n", per_cu); per_cu = 1; }
        (void)hipGetLastError();
        grid = cus * 1;
        fprintf(stderr, "kernel_launch: cus %d per_cu %d grid %d ws %zu need %zu\n", cus, per_cu, grid, ws_size, (size_t)WS_END);
    }
    if (grid < 0) return;
    Params p{};
    p.x = (const float*)d_in[0]; p.ln_mix_g = (const float*)d_in[1]; p.w_in = (const float*)d_in[2]; p.conv_qkv_w = (const float*)d_in[3]; p.A_log = (const float*)d_in[4]; p.dt_bias = (const float*)d_in[5];
    p.gdn_norm_g = (const float*)d_in[6]; p.w_proj_a = (const float*)d_in[7]; p.conv_sc_w = (const float*)d_in[8]; p.w_proj_b = (const float*)d_in[9]; p.w_out = (const float*)d_in[10]; p.ln_ffn_g = (const float*)d_in[11];
    p.w_gate = (const float*)d_in[12]; p.w_up = (const float*)d_in[13]; p.w_down = (const float*)d_in[14]; p.ln_final_g = (const float*)d_in[15];
    p.out = (float*)d_out; p.ws = (unsigned char*)d_ws;
#if N_LAUNCHES == 1
    p.ph_lo = 0; p.ph_hi = NPHASE;
    (void)hipMemsetAsync((char*)d_ws + WS_BAR, 0, XCD_BAR_WORDS * 4, stream);
    void* args[] = {&p};
    hipError_t e = hipLaunchCooperativeKernel((const void*)hybrid_fwd, dim3(grid), dim3(512), args, LDS_BYTES, stream);
    if (e != hipSuccess) fprintf(stderr, "kernel_launch: cooperative launch failed: %s (grid %d)\n", hipGetErrorString(e), grid);
#else
    for (int k = 0; k < NPHASE; ++k) { p.ph_lo = k; p.ph_hi = k + 1; hipLaunchKernelGGL(hybrid_fwd, dim3(grid), dim3(512), LDS_BYTES, stream, p); }
#endif
}
```

```cpp
#include <hip/hip_runtime.h>
#include <hip/hip_cooperative_groups.h>
#include <cstdio>
namespace cg = cooperative_groups;
#define N_LAUNCHES 1
#define TRUNC_MASK 0
#define DUP_MASK 0
namespace pg8 {
#define PG8_LAS __attribute__((address_space(3)))
typedef unsigned short bf16_t;
typedef short bf16x8 __attribute__((ext_vector_type(8)));
typedef float f32x4 __attribute__((ext_vector_type(4)));
typedef unsigned u32x4 __attribute__((ext_vector_type(4)));
constexpr int BM = 256, BK = 64, HALF = 128, HTB = HALF * BK * 2  , STAGE_BYTES = 8 * HTB, NXCD = 8, WGM = 8;

__host__ __device__ __forceinline__ int lds_byte(int r, int c) { const int st = (r >> 4) * 2 + (c >> 5), rr = r & 15, cc = c & 31, ob = rr * 64 + cc * 2; return st * 1024 + (ob ^ (((ob >> 9) & 1) << 5)); }
__host__ __device__ __forceinline__ void stage_rc(int b, int& R, int& C) { const int st = b / 1024, sb = b % 1024, swz = sb ^ (((sb >> 9) & 1) << 5); R = (st >> 1) * 16 + swz / 64; C = (st & 1) * 32 + (swz % 64) / 2; }
__host__ __device__ __forceinline__ int perm32(int rho) { const int n = rho >> 4, i = rho & 15; return 8 * (i >> 2) + 4 * n + (i & 3); }

struct Unit { int pm, pn; };
struct Gemm { const bf16_t* A; const bf16_t* Bt; int M, N, K, lda; };

struct StaticOrder {
    int nM, nN, nwg, G, c;
    __host__ __device__ void init(int M, int N, int G_, int c_) { nM = M / BM; nN = N / BM; nwg = nM * nN; G = G_; c = c_; }
    __host__ __device__ bool next(int i, Unit& u) const {
        const long L = (long)i * G + c; if (L >= nwg) return false;
        int wgid = (int)L; { const int q = nwg / NXCD, r = nwg % NXCD, xcd = wgid % NXCD, off = wgid / NXCD; wgid = (xcd < r ? xcd * (q + 1) : r * (q + 1) + (xcd - r) * q) + off; }
        const int nig = WGM * nN, gid = wgid / nig, fm = gid * WGM, gsz = (nM - fm) < WGM ? (nM - fm) : WGM;
        u.pm = fm + ((wgid % nig) % gsz); u.pn = (wgid % nig) / gsz; return true;
    }
    __device__ __forceinline__ void a_ready(const Unit&) const {}
    __device__ __forceinline__ void done(const Unit&) const {}
};
__device__ __forceinline__ unsigned cvt_pk_bf16(float lo, float hi) { unsigned r; asm volatile("v_cvt_pk_bf16_f32 %0, %1, %2" : "=v"(r) : "v"(lo), "v"(hi)); return r; }
template <class Epi, class Sched, bool STAMP = false>
__device__ __forceinline__ void gemm_phase(PG8_LAS unsigned char* lds, const Gemm g, const Sched& S, const Epi& E, unsigned long long* stamps) {
    const int tid = threadIdx.x, wid = __builtin_amdgcn_readfirstlane(tid >> 6), lane = tid & 63, wr = wid >> 2, wc = wid & 3, fr = lane & 15, fq = lane >> 4;
    const int K = g.K, nt = K / BK;
    int ts_lo = 0, ts_hi = 0, nts = 0; const unsigned long long rt_entry = STAMP ? (unsigned long long)wall_clock64() : 0ull;
#define PG8_STAMP() do { if (STAMP && wid == 0 && nts < 64) { const unsigned long long _c = (unsigned long long)clock64(); \
        ts_lo = (lane == nts) ? (int)(unsigned)_c : ts_lo; ts_hi = (lane == nts) ? (int)(unsigned)(_c >> 32) : ts_hi; ++nts; } } while (0)
    PG8_STAMP();
    unsigned voffA[2], voffB[2];
#pragma unroll
    for (int i = 0; i < 2; ++i) { int R, C; stage_rc(tid * 16 + i * 8192, R, C); const int Rb = Epi::PERM ? ((R & ~31) + perm32(R & 31)) : R;
        voffA[i] = (unsigned)(R * g.lda + C) * 2u; voffB[i] = (unsigned)(Rb * K + C) * 2u; }
    const size_t kstep = (size_t)(BK * 2);
    const size_t hstepA = (size_t)HALF * g.lda * 2, hstepB = (size_t)HALF * K * 2;
    const size_t tstepA = 2 * hstepA, tstepB = 2 * hstepB;
    const unsigned ldsw = (unsigned)wid * 1024u;
    const int aoff = lds_byte(wr * 64 + fr, fq * 8), boff = lds_byte(wc * 32 + fr, fq * 8);
#define PG8_SA(b, h) (((b) * 2 + (h)) * HTB)
#define PG8_SB(b, h) ((4 + (b) * 2 + (h)) * HTB)
#define PG8_STAGE(bufoff, gbase, voff) do { _Pragma("unroll") for (int _i = 0; _i < 2; ++_i) \
        __builtin_amdgcn_global_load_lds((const unsigned*)((const char*)(gbase) + (voff)[_i]), (PG8_LAS unsigned*)(lds + (bufoff) + ldsw + _i * 8192), 16, 0, 0); } while (0)
#define PG8_LDA(dst, b, h) do { _Pragma("unroll") for (int m = 0; m < 4; ++m) _Pragma("unroll") for (int k = 0; k < 2; ++k) dst[m][k] = *(const PG8_LAS bf16x8*)(lds + PG8_SA(b, h) + aoff + m * 2048 + k * 1024); } while (0)
#define PG8_LDB(dst, b, h) do { _Pragma("unroll") for (int n = 0; n < 2; ++n) _Pragma("unroll") for (int k = 0; k < 2; ++k) dst[n][k] = *(const PG8_LAS bf16x8*)(lds + PG8_SB(b, h) + boff + n * 2048 + k * 1024); } while (0)
#define PG8_MMA(ai, bj, At, Bt) do { __builtin_amdgcn_s_setprio(1); _Pragma("unroll") for (int m = 0; m < 4; ++m) _Pragma("unroll") for (int n = 0; n < 2; ++n) _Pragma("unroll") for (int k = 0; k < 2; ++k) \
        acc[ai][bj][m][n] = __builtin_amdgcn_mfma_f32_16x16x32_bf16(Bt[n][k], At[m][k], acc[ai][bj][m][n], 0, 0, 0); __builtin_amdgcn_s_setprio(0); } while (0)
#define PG8_WAIT_V(n) asm volatile("s_waitcnt vmcnt(" #n ")" ::: "memory")
#define PG8_WAIT_L(n) asm volatile("s_waitcnt lgkmcnt(" #n ")" ::: "memory")
#define PG8_BAR __builtin_amdgcn_s_barrier()
#define PG8_SCHED __builtin_amdgcn_sched_barrier(0)
    Unit cur, nxt; int ui = 0;
    if (!S.next(0, cur)) return;
    f32x4 acc[2][2][4][2];
#pragma unroll
    for (int a = 0; a < 2; ++a)
#pragma unroll
        for (int b = 0; b < 2; ++b)
#pragma unroll
            for (int m = 0; m < 4; ++m)
#pragma unroll
                for (int n = 0; n < 2; ++n) acc[a][b][m][n] = (f32x4){0.f, 0.f, 0.f, 0.f};
    bf16x8 At[4][2], B0[2][2], B1[2][2];
    const char* cA = (const char*)g.A + (size_t)cur.pm * tstepA; const char* cB = (const char*)g.Bt + (size_t)cur.pn * tstepB;
    S.a_ready(cur);
    PG8_STAGE(PG8_SB(0, 0), cB, voffB); PG8_STAGE(PG8_SA(0, 0), cA, voffA); PG8_STAGE(PG8_SB(0, 1), cB + hstepB, voffB); PG8_STAGE(PG8_SA(0, 1), cA + hstepA, voffA);
    if (wr == 1) PG8_BAR;
    PG8_WAIT_V(4); PG8_BAR;
    PG8_STAGE(PG8_SB(1, 0), cB + kstep, voffB); PG8_STAGE(PG8_SA(1, 0), cA + kstep, voffA); PG8_STAGE(PG8_SB(1, 1), cB + hstepB + kstep, voffB);
    PG8_WAIT_V(6); PG8_BAR;
    PG8_STAMP();
    for (;;) {
        const bool has_next = S.next(ui + 1, nxt);
        const char* nA = has_next ? (const char*)g.A + (size_t)nxt.pm * tstepA : cA; const char* nB = has_next ? (const char*)g.Bt + (size_t)nxt.pn * tstepB : cB;
        for (int t = 0; t < nt; t += 2) {
            const bool last = (t == nt - 2);
            const char* a1 = cA + (size_t)(t + 1) * kstep;
            const char* a2 = last ? nA : cA + (size_t)(t + 2) * kstep; const char* b2 = last ? nB : cB + (size_t)(t + 2) * kstep;
            const char* a3 = a2 + kstep; const char* b3 = b2 + kstep;
            if (last && has_next) S.a_ready(nxt);
            PG8_LDB(B0, 0, 0); PG8_SCHED; PG8_LDA(At, 0, 0); PG8_STAGE(PG8_SA(1, 1), a1 + hstepA, voffA);
            PG8_WAIT_L(8); PG8_BAR; PG8_WAIT_L(0); PG8_MMA(0, 0, At, B0); PG8_BAR; PG8_SCHED;
            PG8_LDB(B1, 0, 1); PG8_STAGE(PG8_SB(0, 0), b2, voffB);
            PG8_BAR; PG8_WAIT_L(0); PG8_MMA(0, 1, At, B1); PG8_BAR;
            PG8_LDA(At, 0, 1); PG8_STAGE(PG8_SA(0, 0), a2, voffA);
            PG8_BAR; PG8_WAIT_L(0); PG8_MMA(1, 0, At, B0); PG8_BAR; PG8_SCHED;
            PG8_STAGE(PG8_SB(0, 1), b2 + hstepB, voffB);
            PG8_WAIT_V(6); PG8_BAR; PG8_MMA(1, 1, At, B1); PG8_BAR;
            PG8_LDB(B0, 1, 0); PG8_SCHED; PG8_LDA(At, 1, 0); PG8_STAGE(PG8_SA(0, 1), a2 + hstepA, voffA);
            PG8_WAIT_L(8); PG8_BAR; PG8_WAIT_L(0); PG8_MMA(0, 0, At, B0); PG8_BAR; PG8_SCHED;
            PG8_LDB(B1, 1, 1); PG8_STAGE(PG8_SB(1, 0), b3, voffB);
            PG8_BAR; PG8_WAIT_L(0); PG8_MMA(0, 1, At, B1); PG8_BAR;
            PG8_LDA(At, 1, 1); PG8_STAGE(PG8_SA(1, 0), a3, voffA);
            PG8_BAR; PG8_WAIT_L(0); PG8_MMA(1, 0, At, B0); PG8_BAR; PG8_SCHED;
            PG8_STAGE(PG8_SB(1, 1), b3 + hstepB, voffB);
            PG8_WAIT_V(6); PG8_BAR; PG8_MMA(1, 1, At, B1); PG8_BAR;
        }
        PG8_STAMP();
        if constexpr (!Epi::AFTER_DRAIN) { E(acc, cur, wr, wc, fr, fq); S.done(cur); }
        PG8_STAMP();
        if (!has_next) break;
#pragma unroll
        for (int a = 0; a < 2; ++a)
#pragma unroll
            for (int b = 0; b < 2; ++b)
#pragma unroll
                for (int m = 0; m < 4; ++m)
#pragma unroll
                    for (int n = 0; n < 2; ++n) acc[a][b][m][n] = (f32x4){0.f, 0.f, 0.f, 0.f};
        cur = nxt; cA = nA; cB = nB; ++ui;
    }
    PG8_WAIT_V(0);
    if (wr == 0) PG8_BAR;
    PG8_BAR;
    if constexpr (Epi::AFTER_DRAIN) { E.fused(acc, cur, wr, wc, fr, fq, lds, wid, lane); S.done(cur); }
    PG8_STAMP();
    if (STAMP && wid == 0) { stamps[lane] = lane < nts ? (((unsigned long long)(unsigned)ts_hi << 32) | (unsigned)ts_lo) : 0ull;
        if (lane == 62) stamps[62] = rt_entry; if (lane == 63) stamps[63] = (unsigned long long)wall_clock64(); }
#undef PG8_STAMP
#undef PG8_SA
#undef PG8_SB
#undef PG8_STAGE
#undef PG8_LDA
#undef PG8_LDB
#undef PG8_MMA
#undef PG8_WAIT_V
#undef PG8_WAIT_L
#undef PG8_BAR
#undef PG8_SCHED
}
}

#define LAS __attribute__((address_space(3)))
typedef unsigned short bf16_t;
typedef short bf16x8 __attribute__((ext_vector_type(8)));
typedef float f32x4 __attribute__((ext_vector_type(4)));
typedef unsigned u32x4 __attribute__((ext_vector_type(4)));
typedef unsigned u32x2 __attribute__((ext_vector_type(2)));

constexpr int MTOK = 8192, DM = 2048, SEQ = 2048, NH = 16, DFF = 5632, INW = 18464, LDP = 18432;
constexpr int OFF_Q = 0, OFF_K = 2048, OFF_V = 4096, OFF_Z = 6144, OFF_SB = 8192, OFF_SC = 10240, OFF_SH = 12288, OFF_GA = 14336, OFF_GB = 16384;
constexpr float EPS = 1e-6f;
constexpr int NPHASE = 9;
#ifndef N_LAUNCHES
#define N_LAUNCHES 1
#endif

constexpr size_t HAND_UNIT = 73728;
constexpr size_t WS_A0 = 0;
constexpr size_t WS_WIN = WS_A0, WS_XN = WS_A0 + (size_t)LDP * DM * 2;
constexpr size_t WS_HAND = WS_A0, WS_MA = WS_A0, WS_MB = WS_A0 + (size_t)MTOK * DM * 4;
constexpr size_t A0_BYTES = 2048 * HAND_UNIT;
constexpr size_t WS_PROJ = WS_A0 + A0_BYTES;
constexpr size_t WS_H1F = WS_PROJ, WS_H1B = WS_PROJ + (size_t)MTOK * DM * 4, WS_FF = WS_H1B + (size_t)MTOK * DM * 2;
constexpr size_t WS_WA = WS_PROJ + (size_t)MTOK * LDP * 2;
constexpr size_t WS_WB = WS_WA + (size_t)DM * DM * 2, WS_WO = WS_WB + (size_t)DM * DM * 2, WS_WGU = WS_WO + (size_t)DM * DM * 2;
constexpr size_t WS_WD = WS_WGU + (size_t)2 * DFF * DM * 2;
constexpr size_t WS_EGL = WS_WD + (size_t)DM * DFF * 2;
constexpr size_t WS_RSQ1 = WS_EGL + 2048 * 4, WS_WBA = WS_RSQ1 + (size_t)MTOK * 32 * 4, WS_BA = WS_WBA + (size_t)32 * DM * 2, WS_BAR = WS_BA + (size_t)MTOK * 32 * 4, WS_END = WS_BAR + 16384;
static_assert(WS_XN + (size_t)MTOK * DM * 2 <= A0_BYTES && WS_MB + (size_t)MTOK * DM * 2 <= A0_BYTES, "A0 overlays");
static_assert(WS_FF + (size_t)MTOK * DFF * 2 <= WS_WA, "proj overlays");

struct Params {
    const float *x, *ln_mix_g, *w_in, *conv_qkv_w, *A_log, *dt_bias, *gdn_norm_g, *w_proj_a, *conv_sc_w, *w_proj_b, *w_out, *ln_ffn_g, *w_gate, *w_up, *w_down, *ln_final_g;
    float* out; unsigned char* ws; int ph_lo, ph_hi;
};

__device__ __forceinline__ float bf2f(bf16_t u) { return __uint_as_float((unsigned)u << 16); }
__device__ __forceinline__ float bflo(unsigned w) { return __uint_as_float(w << 16); }
__device__ __forceinline__ float bfhi(unsigned w) { return __uint_as_float(w & 0xffff0000u); }
typedef float f32x2_t __attribute__((ext_vector_type(2)));
typedef __bf16 bf16x2_t __attribute__((ext_vector_type(2)));
__device__ __forceinline__ unsigned pk2(float lo, float hi) { const f32x2_t v = {lo, hi}; const bf16x2_t b = __builtin_convertvector(v, bf16x2_t); return __builtin_bit_cast(unsigned, b); }
#ifndef TRUNC_MASK
#define TRUNC_MASK 0
#endif
template <int K> __device__ __forceinline__ unsigned pk2x(float lo, float hi) {
    if ((TRUNC_MASK >> K) & 1) return (__float_as_uint(hi) & 0xffff0000u) | (__float_as_uint(lo) >> 16);
    return pk2(lo, hi);
}
__device__ __forceinline__ float sigmoidf_(float x) { return __builtin_amdgcn_rcpf(1.0f + __expf(-x)); }
__device__ __forceinline__ float siluf_(float x) { return x * __builtin_amdgcn_rcpf(1.0f + __expf(-x)); }
#define LDS_WAIT() asm volatile("s_waitcnt lgkmcnt(0)" ::: "memory")
#define EPI_FENCE() asm volatile("" ::: "memory")
#define LDS_BARRIER() do { asm volatile("s_waitcnt lgkmcnt(0)" ::: "memory"); __builtin_amdgcn_s_barrier(); asm volatile("" ::: "memory"); } while (0)
#define MFMA16(a, b, c) __builtin_amdgcn_mfma_f32_16x16x32_bf16(a, b, c, 0, 0, 0)

using pg8::Unit;
struct EpiProj {
    static constexpr bool PERM = true, AFTER_DRAIN = false;
    bf16_t* O; int ldc;
    __device__ __forceinline__ void operator()(const f32x4 (&acc)[2][2][4][2], const Unit& u, int wr, int wc, int fr, int fq) const {
        const int row0 = u.pm * 256 + wr * 64 + fr, col0 = u.pn * 256 + wc * 32 + 8 * fq;
#pragma unroll
        for (int ai = 0; ai < 2; ++ai)
#pragma unroll
            for (int m = 0; m < 4; ++m) { bf16_t* rowp = O + (size_t)(row0 + ai * 128 + m * 16) * ldc + col0;
#pragma unroll
                for (int bj = 0; bj < 2; ++bj) { const f32x4 v0 = acc[ai][bj][m][0], v1 = acc[ai][bj][m][1];
                    u32x4 w; w.x = pk2x<0>(v0[0], v0[1]); w.y = pk2x<0>(v0[2], v0[3]); w.z = pk2x<0>(v1[0], v1[1]); w.w = pk2x<0>(v1[2], v1[3]);
                    *(u32x4*)(rowp + bj * 128) = w; } }
    }
};
struct EpiMergeA {
    static constexpr bool PERM = true, AFTER_DRAIN = false;
    float* mA; const bf16_t* proj;
    __device__ __forceinline__ void operator()(const f32x4 (&acc)[2][2][4][2], const Unit& u, int wr, int wc, int fr, int fq) const {
        const int row0 = u.pm * 256 + wr * 64 + fr, col0 = u.pn * 256 + wc * 32 + 8 * fq;
#pragma unroll
        for (int ai = 0; ai < 2; ++ai) {
            u32x4 g[4][2];
#pragma unroll
            for (int m = 0; m < 4; ++m)
#pragma unroll
                for (int bj = 0; bj < 2; ++bj) g[m][bj] = *(const u32x4*)(proj + (size_t)(row0 + ai * 128 + m * 16) * LDP + OFF_GA + col0 + bj * 128);
            EPI_FENCE();
#pragma unroll
            for (int m = 0; m < 4; ++m) { const size_t row = (size_t)(row0 + ai * 128 + m * 16);
#pragma unroll
                for (int bj = 0; bj < 2; ++bj) { const int col = col0 + bj * 128; const u32x4 gg = g[m][bj];
                    const f32x4 v0 = acc[ai][bj][m][0], v1 = acc[ai][bj][m][1];
                    f32x4 o0, o1;
                    o0[0] = sigmoidf_(bflo(gg.x)) * v0[0]; o0[1] = sigmoidf_(bfhi(gg.x)) * v0[1]; o0[2] = sigmoidf_(bflo(gg.y)) * v0[2]; o0[3] = sigmoidf_(bfhi(gg.y)) * v0[3];
                    o1[0] = sigmoidf_(bflo(gg.z)) * v1[0]; o1[1] = sigmoidf_(bfhi(gg.z)) * v1[1]; o1[2] = sigmoidf_(bflo(gg.w)) * v1[2]; o1[3] = sigmoidf_(bfhi(gg.w)) * v1[3];
                    float* op = mA + row * DM + col; *(f32x4*)op = o0; *(f32x4*)(op + 4) = o1; } }
            EPI_FENCE();
        }
    }
};
struct EpiMergeB {
    static constexpr bool PERM = true, AFTER_DRAIN = false;
    const float* mA; bf16_t* mg; const bf16_t* proj;
    __device__ __forceinline__ void operator()(const f32x4 (&acc)[2][2][4][2], const Unit& u, int wr, int wc, int fr, int fq) const {
        const int row0 = u.pm * 256 + wr * 64 + fr, col0 = u.pn * 256 + wc * 32 + 8 * fq;
#pragma unroll
        for (int ai = 0; ai < 2; ++ai)
#pragma unroll
            for (int mh = 0; mh < 2; ++mh) {
                u32x4 g[2][2]; f32x4 a0[2][2], a1[2][2];
#pragma unroll
                for (int mm = 0; mm < 2; ++mm)
#pragma unroll
                    for (int bj = 0; bj < 2; ++bj) { const size_t row = (size_t)(row0 + ai * 128 + (2 * mh + mm) * 16); const int col = col0 + bj * 128;
                        g[mm][bj] = *(const u32x4*)(proj + row * LDP + OFF_GB + col);
                        const float* ip = mA + row * DM + col; a0[mm][bj] = *(const f32x4*)ip; a1[mm][bj] = *(const f32x4*)(ip + 4); }
                EPI_FENCE();
#pragma unroll
                for (int mm = 0; mm < 2; ++mm)
#pragma unroll
                    for (int bj = 0; bj < 2; ++bj) { const int m = 2 * mh + mm; const size_t row = (size_t)(row0 + ai * 128 + m * 16); const int col = col0 + bj * 128;
                        const u32x4 gg = g[mm][bj]; const f32x4 b0 = a0[mm][bj], b1 = a1[mm][bj];
                        const f32x4 v0 = acc[ai][bj][m][0], v1 = acc[ai][bj][m][1];
                        f32x4 o0, o1;
                        o0[0] = b0[0] + sigmoidf_(bflo(gg.x)) * v0[0]; o0[1] = b0[1] + sigmoidf_(bfhi(gg.x)) * v0[1]; o0[2] = b0[2] + sigmoidf_(bflo(gg.y)) * v0[2]; o0[3] = b0[3] + sigmoidf_(bfhi(gg.y)) * v0[3];
                        o1[0] = b1[0] + sigmoidf_(bflo(gg.z)) * v1[0]; o1[1] = b1[1] + sigmoidf_(bfhi(gg.z)) * v1[1]; o1[2] = b1[2] + sigmoidf_(bflo(gg.w)) * v1[2]; o1[3] = b1[3] + sigmoidf_(bfhi(gg.w)) * v1[3];
                        u32x4 w; w.x = pk2x<4>(o0[0], o0[1]); w.y = pk2x<4>(o0[2], o0[3]); w.z = pk2x<4>(o1[0], o1[1]); w.w = pk2x<4>(o1[2], o1[3]);
                        *(u32x4*)(mg + row * DM + col) = w; }
                EPI_FENCE();
            }
    }
};
struct EpiResid {
    static constexpr bool PERM = false, AFTER_DRAIN = false;
    const float* base; float* of; bf16_t* ob; float* rowsq;
    __device__ __forceinline__ void operator()(const f32x4 (&acc)[2][2][4][2], const Unit& u, int wr, int wc, int fr, int fq) const {
        const int row0 = u.pm * 256 + wr * 64 + fr, col0 = u.pn * 256 + wc * 32 + 4 * fq;
#pragma unroll
        for (int ai = 0; ai < 2; ++ai)
#pragma unroll
            for (int mh = 0; mh < 2; ++mh) {
                f32x4 bv[2][2][2];
#pragma unroll
                for (int mm = 0; mm < 2; ++mm)
#pragma unroll
                    for (int bj = 0; bj < 2; ++bj)
#pragma unroll
                        for (int n = 0; n < 2; ++n) bv[mm][bj][n] = *(const f32x4*)(base + (size_t)(row0 + ai * 128 + (2 * mh + mm) * 16) * DM + col0 + bj * 128 + n * 16);
                EPI_FENCE();
#pragma unroll
                for (int mm = 0; mm < 2; ++mm) { const int m = 2 * mh + mm; const size_t row = (size_t)(row0 + ai * 128 + m * 16); float ss = 0.f;
#pragma unroll
                    for (int bj = 0; bj < 2; ++bj)
#pragma unroll
                        for (int n = 0; n < 2; ++n) { const size_t off = row * DM + col0 + bj * 128 + n * 16;
                            const f32x4 hv = bv[mm][bj][n] + acc[ai][bj][m][n];
                            *(f32x4*)(of + off) = hv;
                            if (ob) { u32x2 w; w.x = pk2x<4>(hv[0], hv[1]); w.y = pk2x<4>(hv[2], hv[3]); *(u32x2*)(ob + off) = w; }
                            ss += (hv[0] * hv[0] + hv[1] * hv[1]) + (hv[2] * hv[2] + hv[3] * hv[3]); }
                    ss += __shfl_xor(ss, 16); ss += __shfl_xor(ss, 32);
                    if (rowsq && fq == 0) rowsq[row * 32 + u.pn * 4 + wc] = ss; }
                EPI_FENCE();
            }
    }
};
struct EpiFFN {
    static constexpr bool PERM = true, AFTER_DRAIN = false;
    bf16_t* ff; const float* rowsq;
    __device__ __forceinline__ void operator()(const f32x4 (&acc)[2][2][4][2], const Unit& u, int wr, int wc, int fr, int fq) const {
        const int row0 = u.pm * 256 + wr * 64 + fr, col0 = u.pn * 128 + wc * 32 + 8 * fq;
#pragma unroll
        for (int ai = 0; ai < 2; ++ai)
#pragma unroll
            for (int mh = 0; mh < 2; ++mh) {
                f32x4 t[2][8];
#pragma unroll
                for (int mm = 0; mm < 2; ++mm)
#pragma unroll
                    for (int q4 = 0; q4 < 8; ++q4) t[mm][q4] = *(const f32x4*)(rowsq + (size_t)(row0 + ai * 128 + (2 * mh + mm) * 16) * 32 + 4 * q4);
                EPI_FENCE();
#pragma unroll
                for (int mm = 0; mm < 2; ++mm) { const int m = 2 * mh + mm; const size_t row = (size_t)(row0 + ai * 128 + m * 16);
                    float sq = 0.f;
#pragma unroll
                    for (int q4 = 0; q4 < 8; ++q4) sq += (t[mm][q4][0] + t[mm][q4][1]) + (t[mm][q4][2] + t[mm][q4][3]);
                    const float rs = rsqrtf(sq * (1.0f / DM) + EPS);
                    float o[8];
#pragma unroll
                    for (int n = 0; n < 2; ++n)
#pragma unroll
                        for (int j = 0; j < 4; ++j) { const float gt = acc[ai][0][m][n][j] * rs, up = acc[ai][1][m][n][j] * rs; o[n * 4 + j] = siluf_(gt) * up; }
                    u32x4 w; w.x = pk2x<4>(o[0], o[1]); w.y = pk2x<4>(o[2], o[3]); w.z = pk2x<4>(o[4], o[5]); w.w = pk2x<4>(o[6], o[7]);
                    *(u32x4*)(ff + row * DFF + col0) = w; }
                EPI_FENCE();
            }
    }
};

__device__ __forceinline__ void transpose_tile2(const float* __restrict__ W, int N, int K, bf16_t* WT_lo, size_t row_lo, bf16_t* WT_hi, size_t row_hi, const float* kscale, LAS unsigned* scr, int k0, int n0, int lane) {
    const int q = lane >> 4, c = lane & 15;
    f32x4 v[16];
    const bool ok = (n0 + 4 * c) < N;
#pragma unroll
    for (int i = 0; i < 16; ++i) { const int kk = 8 * (i >> 1) + 2 * q + (i & 1);
        v[i] = ok ? *(const f32x4*)(W + (size_t)(k0 + kk) * N + n0 + 4 * c) : (f32x4){0.f, 0.f, 0.f, 0.f}; }
    if (kscale) {
#pragma unroll
        for (int i = 0; i < 16; ++i) v[i] = v[i] * kscale[k0 + 8 * (i >> 1) + 2 * q + (i & 1)];
    }
#pragma unroll
    for (int m = 0; m < 8; ++m)
#pragma unroll
        for (int e = 0; e < 4; ++e) scr[(4 * c + e) * 33 + 4 * m + q] = pk2(v[2 * m][e], v[2 * m + 1][e]);
    LDS_WAIT();
    const int rr = lane >> 3, ch = lane & 7;
#pragma unroll
    for (int j = 0; j < 8; ++j) { const int n = 8 * j + rr; const LAS unsigned* sp = scr + n * 33 + 4 * ch;
        u32x4 o; o.x = sp[0]; o.y = sp[1]; o.z = sp[2]; o.w = sp[3];
        if (j < 4) { *(u32x4*)(WT_lo + (row_lo + n) * (size_t)K + k0 + 8 * ch) = o; }
        else if (WT_hi) { *(u32x4*)(WT_hi + (row_hi + (n - 32)) * (size_t)K + k0 + 8 * ch) = o; } }
    LDS_WAIT();
}
__device__ __forceinline__ void transpose_tile(const float* __restrict__ W, int N, int K, bf16_t* WT, size_t dst_row0, const float* kscale, LAS unsigned* scr, int k0, int n0, int lane) {
    transpose_tile2(W, N, K, WT, dst_row0, WT, dst_row0 + 32, kscale, scr, k0, n0, lane);
}
__device__ __forceinline__ float wave_sum(float v) {
#pragma unroll
    for (int o = 1; o < 64; o <<= 1) v += __shfl_xor(v, o);
    return v;
}
__device__ __forceinline__ void convert_late_weights(const Params& p, LAS unsigned char* lds, int gw, int NGW) {
    const int lane = threadIdx.x & 63, wave = __builtin_amdgcn_readfirstlane(threadIdx.x >> 6);
    LAS unsigned* scr = (LAS unsigned*)(lds + wave * 8448);
    unsigned char* ws = p.ws;
    constexpr int I_SQ = 32 * 32, I_GU = 32 * 88, I_D = 88 * 32;
    constexpr int NITEMS = 3 * I_SQ + 2 * I_GU + I_D;
    for (int it = gw; it < NITEMS; it += NGW) {
        int r = it;
        if (r < I_SQ) { const int kb = r / 32, nb = r % 32; transpose_tile(p.w_proj_a, DM, DM, (bf16_t*)(ws + WS_WA), (size_t)64 * nb, nullptr, scr, 64 * kb, 64 * nb, lane); continue; } r -= I_SQ;
        if (r < I_SQ) { const int kb = r / 32, nb = r % 32; transpose_tile(p.w_proj_b, DM, DM, (bf16_t*)(ws + WS_WB), (size_t)64 * nb, nullptr, scr, 64 * kb, 64 * nb, lane); continue; } r -= I_SQ;
        if (r < I_SQ) { const int kb = r / 32, nb = r % 32; transpose_tile(p.w_out, DM, DM, (bf16_t*)(ws + WS_WO), (size_t)64 * nb, nullptr, scr, 64 * kb, 64 * nb, lane); continue; } r -= I_SQ;
        if (r < I_GU) { const int kb = r / 88, nb = r % 88, n0 = 64 * nb; transpose_tile(p.w_gate, DFF, DM, (bf16_t*)(ws + WS_WGU), (size_t)((n0 >> 7) * 256 + (n0 & 127)), p.ln_ffn_g, scr, 64 * kb, n0, lane); continue; } r -= I_GU;
        if (r < I_GU) { const int kb = r / 88, nb = r % 88, n0 = 64 * nb; transpose_tile(p.w_up, DFF, DM, (bf16_t*)(ws + WS_WGU), (size_t)((n0 >> 7) * 256 + 128 + (n0 & 127)), p.ln_ffn_g, scr, 64 * kb, n0, lane); continue; } r -= I_GU;
        { const int kb = r / 32, nb = r % 32; transpose_tile(p.w_down, DM, DFF, (bf16_t*)(ws + WS_WD), (size_t)64 * nb, nullptr, scr, 64 * kb, 64 * nb, lane); }
    }
}
__device__ __forceinline__ void phase0(const Params& p, LAS unsigned char* lds) {
    const int tid = threadIdx.x, lane = tid & 63, wave = __builtin_amdgcn_readfirstlane(tid >> 6);
    const int gw = blockIdx.x * 8 + wave, NGW = gridDim.x * 8;
    LAS unsigned* scr = (LAS unsigned*)(lds + wave * 8448);
    unsigned char* ws = p.ws;
    constexpr int NT_IN = 289, I_IN = 32 * NT_IN;
    for (int it = gw; it < I_IN; it += NGW) { const int kb = it / NT_IN, nb = it % NT_IN; bf16_t* wt = (bf16_t*)(ws + WS_WIN);
        if (nb < 128)       transpose_tile(p.w_in, INW, DM, wt, (size_t)64 * nb, nullptr, scr, 64 * kb, 64 * nb, lane);
        else if (nb == 128) transpose_tile2(p.w_in, INW, DM, (bf16_t*)(ws + WS_WBA), 0, wt, 8192, nullptr, scr, 64 * kb, 64 * nb, lane);
        else if (nb < 288)  transpose_tile(p.w_in, INW, DM, wt, (size_t)64 * nb - 32, nullptr, scr, 64 * kb, 64 * nb, lane);
        else                transpose_tile2(p.w_in, INW, DM, wt, (size_t)64 * nb - 32, nullptr, 0, nullptr, scr, 64 * kb, 64 * nb, lane); }
    bf16_t* xn = (bf16_t*)(ws + WS_XN);
    f32x4 gmix[8];
#pragma unroll
    for (int j = 0; j < 8; ++j) gmix[j] = ((const f32x4*)p.ln_mix_g + lane)[64 * j];
    EPI_FENCE();
    for (int m = gw; m < MTOK; m += NGW) {
        const f32x4* xr = (const f32x4*)(p.x + (size_t)m * DM) + lane;
        f32x4 v[8]; float s = 0.f;
#pragma unroll
        for (int j = 0; j < 8; ++j) { v[j] = xr[64 * j]; s += (v[j][0] * v[j][0] + v[j][1] * v[j][1]) + (v[j][2] * v[j][2] + v[j][3] * v[j][3]); }
        const float rs = rsqrtf(wave_sum(s) * (1.0f / DM) + EPS);
        u32x2* o = (u32x2*)(xn + (size_t)m * DM) + lane;
#pragma unroll
        for (int j = 0; j < 8; ++j) { const f32x4 g = gmix[j]; u32x2 w; w.x = pk2(v[j][0] * rs * g[0], v[j][1] * rs * g[1]); w.y = pk2(v[j][2] * rs * g[2], v[j][3] * rs * g[3]); o[64 * j] = w; }
    }
}

__device__ __forceinline__ void conv4_rows(const bf16_t* base, int r0, int t0, const float* cw, float (&out)[4][8]) {
    float w[4][8];
#pragma unroll
    for (int i = 0; i < 4; ++i) { const f32x4 a = *(const f32x4*)(cw + i * 6144), b = *(const f32x4*)(cw + i * 6144 + 4);
        w[i][0] = a[0]; w[i][1] = a[1]; w[i][2] = a[2]; w[i][3] = a[3]; w[i][4] = b[0]; w[i][5] = b[1]; w[i][6] = b[2]; w[i][7] = b[3]; }
    float x[7][8];
#pragma unroll
    for (int i = 0; i < 7; ++i) { const int rr = r0 - 3 + i; u32x4 v = (u32x4){0u, 0u, 0u, 0u};
        if (t0 + rr >= 0) v = *(const u32x4*)(base + (ptrdiff_t)rr * LDP);
        x[i][0] = bflo(v.x); x[i][1] = bfhi(v.x); x[i][2] = bflo(v.y); x[i][3] = bfhi(v.y); x[i][4] = bflo(v.z); x[i][5] = bfhi(v.z); x[i][6] = bflo(v.w); x[i][7] = bfhi(v.w); }
#pragma unroll
    for (int r = 0; r < 4; ++r)
#pragma unroll
        for (int j = 0; j < 8; ++j) { const float y = (w[0][j] * x[r][j] + w[1][j] * x[r + 1][j]) + (w[2][j] * x[r + 2][j] + w[3][j] * x[r + 3][j]); out[r][j] = siluf_(y); }
}
constexpr int P2_GRP = 68608;
__device__ __forceinline__ void phase2(const Params& p, LAS unsigned char* lds) {
    const int tid = threadIdx.x, grp = __builtin_amdgcn_readfirstlane(tid >> 8), lane = tid & 63, wvg = __builtin_amdgcn_readfirstlane((tid >> 6) & 3); int gt = tid & 255;
    unsigned char* ws = p.ws;
    const bf16_t* proj = (const bf16_t*)(ws + WS_PROJ);
    LAS unsigned char* gl = lds + grp * P2_GRP;
    LAS float* kn = (LAS float*)gl; LAS float* qn = (LAS float*)(gl + 33792);
    LAS float* Am = (LAS float*)(gl + 33792);
    LAS float* sbeta = (LAS float*)(gl + 67584); LAS float* sgc = sbeta + 64; LAS float* srsw = sbeta + 128;
    for (int item = blockIdx.x; item < 1024; item += gridDim.x) {
        asm volatile("" : "+v"(gt));
        const int unit = item * 2 + grp;
        const int b = unit >> 9, h = (unit >> 5) & 15, n = unit & 31, t0 = n * 64;
        const bf16_t* prow = proj + ((size_t)b * SEQ + t0) * LDP;
        unsigned char* hand = ws + WS_HAND + (size_t)unit * HAND_UNIT;
        bf16_t* w_g = (bf16_t*)hand; bf16_t* qd_g = (bf16_t*)(hand + 16384); bf16_t* kdT_g = (bf16_t*)(hand + 32768); bf16_t* uT_g = (bf16_t*)(hand + 49152); bf16_t* at_g = (bf16_t*)(hand + 65536);
        if (wvg == 0) {
            const float* bap = (const float*)(ws + WS_BA) + ((size_t)b * SEQ + t0 + gt) * 32; const float bb = bap[h], aa = bap[16 + h];
            const float xs = aa + p.dt_bias[h]; const float sp = xs > 20.f ? xs : __logf(1.0f + __expf(xs));
            float g = -__expf(p.A_log[h]) * sp;
#pragma unroll
            for (int o = 1; o < 64; o <<= 1) { const float t = __shfl_up(g, o); if (lane >= o) g += t; }
            sbeta[gt] = sigmoidf_(bb); sgc[gt] = g;
            if (gt == 63) ((float*)(ws + WS_EGL))[unit] = __expf(g);
        }
        const int r0 = (gt >> 4) * 4, c0 = (gt & 15) * 8;
        float qv[4][8], kv[4][8]; float rnk[4];
#ifndef P2REP_A
#define P2REP_A 1
#define P2REP_B 1
#define P2REP_C 1
#endif
        for (int rpa = 0; rpa < P2REP_A; ++rpa) {
        if (P2REP_A > 1) asm volatile("" ::: "memory");
        conv4_rows(prow + OFF_Q + h * 128 + c0, r0, t0, p.conv_qkv_w + OFF_Q + h * 128 + c0, qv);
        conv4_rows(prow + OFF_K + h * 128 + c0, r0, t0, p.conv_qkv_w + OFF_K + h * 128 + c0, kv);
#pragma unroll
        for (int r = 0; r < 4; ++r) { float sq = 0.f, sk = 0.f;
#pragma unroll
            for (int j = 0; j < 8; ++j) { sq += qv[r][j] * qv[r][j]; sk += kv[r][j] * kv[r][j]; }
#pragma unroll
            for (int o = 1; o < 16; o <<= 1) { sq += __shfl_xor(sq, o); sk += __shfl_xor(sk, o); }
            const float rq = rsqrtf(sq + EPS) * 0.08838834764831845f; rnk[r] = rsqrtf(sk + EPS);
#pragma unroll
            for (int j = 0; j < 8; ++j) { qv[r][j] *= rq; kv[r][j] *= rnk[r]; } }
        }
        LDS_BARRIER();
        const float gcl = sgc[63];
        float ekl[4];
#pragma unroll
        for (int r = 0; r < 4; ++r) { const int row = r0 + r; const float gc = sgc[row], eg = __expf(gc); ekl[r] = __expf(gcl - gc);
            u32x4 wd;
            *(LAS f32x4*)(qn + row * 132 + c0) = (f32x4){qv[r][0], qv[r][1], qv[r][2], qv[r][3]}; *(LAS f32x4*)(qn + row * 132 + c0 + 4) = (f32x4){qv[r][4], qv[r][5], qv[r][6], qv[r][7]};
            *(LAS f32x4*)(kn + row * 132 + c0) = (f32x4){kv[r][0], kv[r][1], kv[r][2], kv[r][3]}; *(LAS f32x4*)(kn + row * 132 + c0 + 4) = (f32x4){kv[r][4], kv[r][5], kv[r][6], kv[r][7]};
            wd.x = pk2x<1>(qv[r][0] * eg, qv[r][1] * eg); wd.y = pk2x<1>(qv[r][2] * eg, qv[r][3] * eg); wd.z = pk2x<1>(qv[r][4] * eg, qv[r][5] * eg); wd.w = pk2x<1>(qv[r][6] * eg, qv[r][7] * eg);
            *(u32x4*)(qd_g + row * 128 + c0) = wd;
            if ((gt & 15) == 0) srsw[row] = rnk[r] * sbeta[row] * eg; }
#pragma unroll
        for (int j = 0; j < 8; ++j) { u32x2 w; w.x = pk2x<1>(kv[0][j] * ekl[0], kv[1][j] * ekl[1]); w.y = pk2x<1>(kv[2][j] * ekl[2], kv[3][j] * ekl[3]); *(u32x2*)(kdT_g + (c0 + j) * 64 + r0) = w; }
        LDS_BARRIER();
        {
            const int wv = wvg, lr = lane & 15, lq = lane >> 4;
            f32x4 aK[4], aQ[4];
#pragma unroll
            for (int jb = 0; jb < 4; ++jb) { aK[jb] = (f32x4){0.f, 0.f, 0.f, 0.f}; aQ[jb] = (f32x4){0.f, 0.f, 0.f, 0.f}; }
#pragma unroll 2
            for (int kk = 0; kk < 8; ++kk) {
                const f32x4 ka = *(const LAS f32x4*)(kn + (16 * wv + lr) * 132 + 16 * kk + 4 * lq), qa = *(const LAS f32x4*)(qn + (16 * wv + lr) * 132 + 16 * kk + 4 * lq);
#pragma unroll
                for (int jb = 0; jb < 4; ++jb) if (jb <= wv) {
                    const f32x4 kb = *(const LAS f32x4*)(kn + (16 * jb + lr) * 132 + 16 * kk + 4 * lq);
#pragma unroll
                    for (int e = 0; e < 4; ++e) { aK[jb] = __builtin_amdgcn_mfma_f32_16x16x4f32(ka[e], kb[e], aK[jb], 0, 0, 0); aQ[jb] = __builtin_amdgcn_mfma_f32_16x16x4f32(qa[e], kb[e], aQ[jb], 0, 0, 0); }
                }
            }
            LDS_BARRIER();
#pragma unroll
            for (int jb = 0; jb < 4; ++jb) {
                const int j = 16 * jb + lr; const float gcj = sgc[j];
#pragma unroll
                for (int r = 0; r < 4; ++r) { const int i = 16 * wv + 4 * lq + r;
                    const float dec = (i >= j) ? __expf(sgc[i] - gcj) : 0.f;
                    Am[i * 64 + j] = (i > j) ? sbeta[i] * aK[jb][r] * dec : 0.f;
                    at_g[i * 64 + j] = (bf16_t)(pk2x<1>(aQ[jb][r] * dec, 0.f) & 0xffffu); }
            }
        }
        float X[64];
        {
            const bool isv = wvg < 2; const int cc = gt & 127;
            const int col = (isv ? OFF_V : OFF_K) + h * 128 + cc;
            const float* cwp = p.conv_qkv_w + col;
            const float w0 = cwp[0], w1 = cwp[6144], w2 = cwp[2 * 6144], w3 = cwp[3 * 6144];
            const LAS float* scl = isv ? sbeta : srsw;
            const bf16_t* pc = prow + col;
            float x0 = 0.f, x1 = 0.f, x2 = 0.f;
            if (t0 > 0) { x0 = bf2f(pc[-3 * (ptrdiff_t)LDP]); x1 = bf2f(pc[-2 * (ptrdiff_t)LDP]); x2 = bf2f(pc[-(ptrdiff_t)LDP]); }
#pragma unroll
            for (int blk = 0; blk < 4; ++blk) {
                bf16_t raw[16];
#pragma unroll
                for (int e = 0; e < 16; ++e) raw[e] = pc[(size_t)(16 * blk + e) * LDP];
                asm volatile("" ::: "memory");
#pragma unroll
                for (int e = 0; e < 16; ++e) { const int i = 16 * blk + e; const float x3 = bf2f(raw[e]); const float y = (w0 * x0 + w1 * x1) + (w2 * x2 + w3 * x3); X[i] = siluf_(y) * scl[i]; x0 = x1; x1 = x2; x2 = x3; }
            }
        }
        LDS_BARRIER();
#pragma unroll
        for (int i = 1; i < 64; ++i) {
            float xa = X[i], xb = 0.f;
#pragma unroll
            for (int j4 = 0; j4 < (i + 3) / 4; ++j4) {
                const f32x4 a = *(const LAS f32x4*)(Am + i * 64 + 4 * j4);
                if (j4 & 1) { xb -= a[0] * X[4 * j4]; xb -= a[1] * X[4 * j4 + 1]; xb -= a[2] * X[4 * j4 + 2]; xb -= a[3] * X[4 * j4 + 3]; }
                else        { xa -= a[0] * X[4 * j4]; xa -= a[1] * X[4 * j4 + 1]; xa -= a[2] * X[4 * j4 + 2]; xa -= a[3] * X[4 * j4 + 3]; }
            }
            X[i] = xa + xb;
        }
        if (wvg < 2) {
#pragma unroll
            for (int i8 = 0; i8 < 8; ++i8) { u32x4 w; w.x = pk2x<1>(X[8 * i8], X[8 * i8 + 1]); w.y = pk2x<1>(X[8 * i8 + 2], X[8 * i8 + 3]); w.z = pk2x<1>(X[8 * i8 + 4], X[8 * i8 + 5]); w.w = pk2x<1>(X[8 * i8 + 6], X[8 * i8 + 7]);
                *(u32x4*)(uT_g + (gt & 127) * 64 + 8 * i8) = w; }
        } else {
#pragma unroll
            for (int i = 0; i < 64; ++i) w_g[i * 128 + (gt & 127)] = (bf16_t)(pk2x<1>(X[i], 0.f) & 0xffffu);
        }
    }
}
__device__ __forceinline__ void phase2_mixer(const Params& p, int first, int stride) {
    const int tid = threadIdx.x; unsigned char* ws = p.ws;
    {
        bf16_t* projw = (bf16_t*)(ws + WS_PROJ);
        for (int item = first; item < 512; item += stride) {
            const int idx = item * 512 + tid; const int c0 = (idx & 255) * 8, r8 = (idx >> 8) * 8; const int t = r8 & (SEQ - 1);
            float w[3][8];
#pragma unroll
            for (int i = 0; i < 3; ++i) { const f32x4 a = *(const f32x4*)(p.conv_sc_w + i * 2048 + c0), bq = *(const f32x4*)(p.conv_sc_w + i * 2048 + c0 + 4);
                w[i][0] = a[0]; w[i][1] = a[1]; w[i][2] = a[2]; w[i][3] = a[3]; w[i][4] = bq[0]; w[i][5] = bq[1]; w[i][6] = bq[2]; w[i][7] = bq[3]; }
            float p0[8], p1[8];
#pragma unroll
            for (int j = 0; j < 8; ++j) { p0[j] = 0.f; p1[j] = 0.f; }
            if (t > 0) {
                const bf16_t* ra = projw + (size_t)(r8 - 2) * LDP; const bf16_t* rb = projw + (size_t)(r8 - 1) * LDP;
                const u32x4 ca = *(const u32x4*)(ra + OFF_SC + c0), ha = *(const u32x4*)(ra + OFF_SH + c0), cb = *(const u32x4*)(rb + OFF_SC + c0), hb = *(const u32x4*)(rb + OFF_SH + c0);
                p0[0] = bflo(ca.x) * bflo(ha.x); p0[1] = bfhi(ca.x) * bfhi(ha.x); p0[2] = bflo(ca.y) * bflo(ha.y); p0[3] = bfhi(ca.y) * bfhi(ha.y);
                p0[4] = bflo(ca.z) * bflo(ha.z); p0[5] = bfhi(ca.z) * bfhi(ha.z); p0[6] = bflo(ca.w) * bflo(ha.w); p0[7] = bfhi(ca.w) * bfhi(ha.w);
                p1[0] = bflo(cb.x) * bflo(hb.x); p1[1] = bfhi(cb.x) * bfhi(hb.x); p1[2] = bflo(cb.y) * bflo(hb.y); p1[3] = bfhi(cb.y) * bfhi(hb.y);
                p1[4] = bflo(cb.z) * bflo(hb.z); p1[5] = bfhi(cb.z) * bfhi(hb.z); p1[6] = bflo(cb.w) * bflo(hb.w); p1[7] = bfhi(cb.w) * bfhi(hb.w);
            }
#pragma unroll
            for (int i = 0; i < 8; ++i) {
                bf16_t* rp = projw + (size_t)(r8 + i) * LDP;
                const u32x4 cv = *(const u32x4*)(rp + OFF_SC + c0), hv = *(const u32x4*)(rp + OFF_SH + c0), bv = *(const u32x4*)(rp + OFF_SB + c0);
                float p2[8], bb[8], o[8];
                p2[0] = bflo(cv.x) * bflo(hv.x); p2[1] = bfhi(cv.x) * bfhi(hv.x); p2[2] = bflo(cv.y) * bflo(hv.y); p2[3] = bfhi(cv.y) * bfhi(hv.y);
                p2[4] = bflo(cv.z) * bflo(hv.z); p2[5] = bfhi(cv.z) * bfhi(hv.z); p2[6] = bflo(cv.w) * bflo(hv.w); p2[7] = bfhi(cv.w) * bfhi(hv.w);
                bb[0] = bflo(bv.x); bb[1] = bfhi(bv.x); bb[2] = bflo(bv.y); bb[3] = bfhi(bv.y); bb[4] = bflo(bv.z); bb[5] = bfhi(bv.z); bb[6] = bflo(bv.w); bb[7] = bfhi(bv.w);
#pragma unroll
                for (int j = 0; j < 8; ++j) { o[j] = bb[j] * (w[0][j] * p0[j] + w[1][j] * p1[j] + w[2][j] * p2[j]); p0[j] = p1[j]; p1[j] = p2[j]; }
                u32x4 wv; wv.x = pk2x<3>(o[0], o[1]); wv.y = pk2x<3>(o[2], o[3]); wv.z = pk2x<3>(o[4], o[5]); wv.w = pk2x<3>(o[6], o[7]);
                *(u32x4*)(rp + OFF_SB + c0) = wv;
            }
        }
    }
}

__device__ __forceinline__ void phase3(const Params& p, LAS unsigned char* lds, bf16_t* oa_base, int oa_ld) {
    const int tid = threadIdx.x, l = tid & 63, wv = __builtin_amdgcn_readfirstlane(tid >> 6), lr = l & 15, lq = l >> 4, tb = wv & 3, vh = wv >> 2, db = wv;
    unsigned char* ws = p.ws;
    LAS bf16_t* ST = (LAS bf16_t*)lds;
    LAS bf16_t* vT = (LAS bf16_t*)(lds + 34816);
    LAS float* oL = (LAS float*)(lds + 53248);
    LAS float* ngL = (LAS float*)(lds + 87040);
    const int prw = tid >> 3, pcs = (tid & 7) * 16;
    for (int bh = blockIdx.x; bh < 64; bh += gridDim.x) {
        const int b = bh >> 4, h = bh & 15;
        __syncthreads();
        for (int i = tid; i < 34816 / 16; i += 512) ((LAS u32x4*)ST)[i] = (u32x4){0u, 0u, 0u, 0u};
        if (tid < 128) ngL[tid] = p.gdn_norm_g[tid];
        f32x4 accS[8];
#pragma unroll
        for (int v = 0; v < 8; ++v) accS[v] = (f32x4){0.f, 0.f, 0.f, 0.f};
        __syncthreads();
        const unsigned char* hand0 = ws + WS_HAND + (size_t)bh * 32 * HAND_UNIT;
        const float* egl_g = (const float*)(ws + WS_EGL) + bh * 32;
        const bf16_t* projz = (const bf16_t*)(ws + WS_PROJ); const unsigned zoff = (unsigned)((b * SEQ + prw) * LDP + OFF_Z + h * 128 + pcs);
        const unsigned ooff = (unsigned)((b * SEQ + prw) * oa_ld + h * 128 + pcs);
        const int o_wq = (16 * tb + lr) * 128 + 8 * lq, o_at = (16 * tb + lr) * 64 + 8 * lq, o_k = (16 * db + lr) * 64 + 8 * lq, o_u = (64 * vh + lr) * 64 + 16 * tb + 4 * lq;
        bf16x8 c_w[4], c_q[4], c_at[2], c_k[2], n_at[2], n_k[2]; u32x2 c_u[4]; u32x4 c_z[2]; float c_e, n_e;
#define P3_LOAD_A(nn) do { const bf16_t* hb_ = (const bf16_t*)(hand0 + (size_t)(nn) * HAND_UNIT); \
        _Pragma("unroll") for (int ks = 0; ks < 4; ++ks) { c_w[ks] = *(const bf16x8*)(hb_ + o_wq + 32 * ks); c_q[ks] = *(const bf16x8*)(hb_ + 8192 + o_wq + 32 * ks); } \
        _Pragma("unroll") for (int j = 0; j < 4; ++j) c_u[j] = *(const u32x2*)(hb_ + 24576 + o_u + 1024 * j); } while (0)
#define P3_LOAD_B(AT_, K_, E_, nn) do { const bf16_t* hb_ = (const bf16_t*)(hand0 + (size_t)(nn) * HAND_UNIT); \
        _Pragma("unroll") for (int ks = 0; ks < 2; ++ks) { AT_[ks] = *(const bf16x8*)(hb_ + 32768 + o_at + 32 * ks); K_[ks] = *(const bf16x8*)(hb_ + 16384 + o_k + 32 * ks); } \
        E_ = egl_g[nn]; } while (0)
#define P3_LOAD_Z(nn) do { const bf16_t* zp_ = projz + (zoff + (unsigned)(nn) * (64u * LDP)); c_z[0] = *(const u32x4*)zp_; c_z[1] = *(const u32x4*)(zp_ + 8); } while (0)
        P3_LOAD_A(0); P3_LOAD_B(c_at, c_k, c_e, 0); P3_LOAD_Z(0);
#define P3_PHASE_C(nc) do { \
            float o[16]; float ss = 0.f; \
            _Pragma("unroll") for (int q4 = 0; q4 < 4; ++q4) { const f32x4 t = *(const LAS f32x4*)(oL + prw * 132 + pcs + 4 * q4); o[4 * q4] = t[0]; o[4 * q4 + 1] = t[1]; o[4 * q4 + 2] = t[2]; o[4 * q4 + 3] = t[3]; \
                ss += (t[0] * t[0] + t[1] * t[1]) + (t[2] * t[2] + t[3] * t[3]); } \
            ss += __shfl_xor(ss, 1); ss += __shfl_xor(ss, 2); ss += __shfl_xor(ss, 4); \
            const float rs = rsqrtf(ss * (1.0f / 128.0f) + EPS); \
            float zf[16]; \
            zf[0] = bflo(c_z[0].x); zf[1] = bfhi(c_z[0].x); zf[2] = bflo(c_z[0].y); zf[3] = bfhi(c_z[0].y); zf[4] = bflo(c_z[0].z); zf[5] = bfhi(c_z[0].z); zf[6] = bflo(c_z[0].w); zf[7] = bfhi(c_z[0].w); \
            zf[8] = bflo(c_z[1].x); zf[9] = bfhi(c_z[1].x); zf[10] = bflo(c_z[1].y); zf[11] = bfhi(c_z[1].y); zf[12] = bflo(c_z[1].z); zf[13] = bfhi(c_z[1].z); zf[14] = bflo(c_z[1].w); zf[15] = bfhi(c_z[1].w); \
            _Pragma("unroll") for (int q4 = 0; q4 < 4; ++q4) { const f32x4 g = *(const LAS f32x4*)(ngL + pcs + 4 * q4); \
                _Pragma("unroll") for (int j = 0; j < 4; ++j) o[4 * q4 + j] = o[4 * q4 + j] * rs * g[j] * siluf_(zf[4 * q4 + j]); } \
            u32x4 w0, w1; \
            w0.x = pk2x<3>(o[0], o[1]); w0.y = pk2x<3>(o[2], o[3]); w0.z = pk2x<3>(o[4], o[5]); w0.w = pk2x<3>(o[6], o[7]); \
            w1.x = pk2x<3>(o[8], o[9]); w1.y = pk2x<3>(o[10], o[11]); w1.z = pk2x<3>(o[12], o[13]); w1.w = pk2x<3>(o[14], o[15]); \
            bf16_t* zp = oa_base + (ooff + (unsigned)(nc) * (64u * (unsigned)oa_ld)); *(u32x4*)zp = w0; *(u32x4*)(zp + 8) = w1; } while (0)
#define P3_STEP(n, WITH_C) do { \
            const int nn = (n) < 31 ? (n) + 1 : 31; \
            P3_LOAD_B(n_at, n_k, n_e, nn); \
            f32x4 accV[4], accO[4]; \
            _Pragma("unroll") for (int j = 0; j < 4; ++j) { accV[j] = (f32x4){0.f, 0.f, 0.f, 0.f}; accO[j] = (f32x4){0.f, 0.f, 0.f, 0.f}; } \
            _Pragma("unroll") for (int kh = 0; kh < 2; ++kh) { bf16x8 SB[4][2]; \
              _Pragma("unroll") for (int j = 0; j < 4; ++j) _Pragma("unroll") for (int k2 = 0; k2 < 2; ++k2) SB[j][k2] = *(const LAS bf16x8*)(ST + (16 * (4 * vh + j) + lr) * 136 + 32 * (2 * kh + k2) + 8 * lq); \
              _Pragma("unroll") for (int k2 = 0; k2 < 2; ++k2) _Pragma("unroll") for (int j = 0; j < 4; ++j) { accV[j] = MFMA16(c_w[2 * kh + k2], SB[j][k2], accV[j]); accO[j] = MFMA16(c_q[2 * kh + k2], SB[j][k2], accO[j]); } } \
            if (WITH_C) { P3_PHASE_C((n) - 1); P3_LOAD_Z(n); } \
            _Pragma("unroll") for (int j = 0; j < 4; ++j) { const int vb = 4 * vh + j; \
                const float v0 = bflo(c_u[j].x) - accV[j][0], v1 = bfhi(c_u[j].x) - accV[j][1], v2 = bflo(c_u[j].y) - accV[j][2], v3 = bfhi(c_u[j].y) - accV[j][3]; \
                u32x2 w; w.x = pk2x<2>(v0, v1); w.y = pk2x<2>(v2, v3); \
                *(LAS u32x2*)(vT + (16 * vb + lr) * 72 + 16 * tb + 4 * lq) = w; } \
            P3_LOAD_A(nn); \
            LDS_BARRIER(); \
            { bf16x8 VB[8][2]; \
              _Pragma("unroll") for (int vb = 0; vb < 8; ++vb) _Pragma("unroll") for (int ks = 0; ks < 2; ++ks) VB[vb][ks] = *(const LAS bf16x8*)(vT + (16 * vb + lr) * 72 + 32 * ks + 8 * lq); \
              _Pragma("unroll") for (int ks = 0; ks < 2; ++ks) if (ks == 0 || tb >= 2) { \
                  _Pragma("unroll") for (int j = 0; j < 4; ++j) accO[j] = MFMA16(c_at[ks], vh ? VB[4 + j][ks] : VB[j][ks], accO[j]); } \
              _Pragma("unroll") for (int vb = 0; vb < 8; ++vb) accS[vb] = accS[vb] * c_e; \
              _Pragma("unroll") for (int ks = 0; ks < 2; ++ks) _Pragma("unroll") for (int vb = 0; vb < 8; ++vb) accS[vb] = MFMA16(c_k[ks], VB[vb][ks], accS[vb]); } \
            _Pragma("unroll") for (int j = 0; j < 4; ++j) { const int vb = 4 * vh + j; \
                _Pragma("unroll") for (int r = 0; r < 4; ++r) oL[(16 * tb + 4 * lq + r) * 132 + 16 * vb + lr] = accO[j][r]; } \
            _Pragma("unroll") for (int vb = 0; vb < 8; ++vb) { u32x2 w; w.x = pk2x<2>(accS[vb][0], accS[vb][1]); w.y = pk2x<2>(accS[vb][2], accS[vb][3]); \
                *(LAS u32x2*)(ST + (16 * vb + lr) * 136 + 16 * db + 4 * lq) = w; } \
            LDS_BARRIER(); \
            c_at[0] = n_at[0]; c_at[1] = n_at[1]; c_k[0] = n_k[0]; c_k[1] = n_k[1]; c_e = n_e; } while (0)
        P3_STEP(0, false);
        for (int n = 1; n < 32; ++n) P3_STEP(n, true);
        P3_PHASE_C(31);
#undef P3_STEP
#undef P3_PHASE_C
#undef P3_LOAD_A
#undef P3_LOAD_B
#undef P3_LOAD_Z
    }
}

__device__ __forceinline__ void phase8(const Params& p) {
    const int tid = threadIdx.x, lane = tid & 63, wave = __builtin_amdgcn_readfirstlane(tid >> 6);
    const int gw = blockIdx.x * 8 + wave, NGW = gridDim.x * 8;
    f32x4 gfin[8];
#pragma unroll
    for (int j = 0; j < 8; ++j) gfin[j] = ((const f32x4*)p.ln_final_g + lane)[64 * j];
    EPI_FENCE();
    for (int m = gw; m < MTOK; m += NGW) {
        f32x4* xr = (f32x4*)(p.out + (size_t)m * DM) + lane;
        f32x4 v[8]; float s = 0.f;
#pragma unroll
        for (int j = 0; j < 8; ++j) { v[j] = xr[64 * j]; s += (v[j][0] * v[j][0] + v[j][1] * v[j][1]) + (v[j][2] * v[j][2] + v[j][3] * v[j][3]); }
        const float rs = rsqrtf(wave_sum(s) * (1.0f / DM) + EPS);
#pragma unroll
        for (int j = 0; j < 8; ++j) xr[64 * j] = v[j] * rs * gfin[j];
    }
}

#define XB_TMO      128
#define XB_XCNT(j)  (256  + 64 * (j))
#define XB_XSUB(j)  (1280 + 64 * (j))
#define XB_XGEN(j)  (2304 + 64 * (j))
#define XB_TOP      3328
#define XB_TOPGEN   3392
#define XCD_BAR_WORDS 3456
#define XB_SPIN_CAP (1u << 18)
__device__ __forceinline__ unsigned xb_ld(unsigned* p)              { return __hip_atomic_load(p, __ATOMIC_RELAXED, __HIP_MEMORY_SCOPE_AGENT); }
__device__ __forceinline__ unsigned xb_add(unsigned* p, unsigned v) { return __hip_atomic_fetch_add(p, v, __ATOMIC_RELAXED, __HIP_MEMORY_SCOPE_AGENT); }
__device__ __forceinline__ unsigned xb_xcc_id() { return (unsigned)__builtin_amdgcn_s_getreg((3 << 11) | 20) & 0xFu; }
#define XB_SPIN(cond, bar) do { unsigned _sp = 0; while (cond) { __builtin_amdgcn_s_sleep(1); \
    if ((++_sp & 255u) == 0u) { if (xb_ld(&(bar)[XB_TMO])) break; if (_sp > XB_SPIN_CAP) { atomicAdd(&(bar)[XB_TMO], 1u); break; } } } } while (0)

struct XcdBarrier {
    unsigned* bar; unsigned x;
    volatile LAS unsigned* st;
};

__device__ __forceinline__ XcdBarrier xcd_barrier_post(unsigned* bar, volatile LAS unsigned* st) {
    XcdBarrier b; b.bar = bar; b.x = xb_xcc_id(); b.st = st;
    if (threadIdx.x == 0) (void)xb_add(&bar[XB_XCNT(b.x)], 1u);
    return b;
}
__device__ __forceinline__ void xcd_barrier_complete(unsigned* bar, unsigned x, unsigned& nloc, unsigned& nx) {
    const unsigned G = gridDim.x * gridDim.y * gridDim.z;
    unsigned sum, cnt, mine, sp = 0u;
    for (;;) {
        sum = 0u; cnt = 0u; mine = 0u;
#pragma unroll
        for (unsigned j = 0; j < 16; ++j) { const unsigned c = xb_ld(&bar[XB_XCNT(j)]); sum += c; cnt += (c > 0u) ? 1u : 0u; mine = (j == x) ? c : mine; }
        if (sum == G) break;
        __builtin_amdgcn_s_sleep(1);
        if ((++sp & 255u) == 0u) { if (xb_ld(&bar[XB_TMO])) break; if (sp > XB_SPIN_CAP) { atomicAdd(&bar[XB_TMO], 1u); break; } }
    }
    nloc = mine > 0u ? mine : 1u; nx = cnt > 0u ? cnt : 1u;
}

__device__ __forceinline__ void xcd_barrier(const XcdBarrier& b) {
    asm volatile("s_waitcnt vmcnt(0)" ::: "memory");
    __syncthreads();
    if (threadIdx.x == 0) {
        unsigned* bar = b.bar;
        __builtin_amdgcn_s_waitcnt(0);
        unsigned nloc = b.st[0], nx = b.st[1];
        if (nloc == 0u) { xcd_barrier_complete(bar, b.x, nloc, nx); b.st[0] = nloc; b.st[1] = nx; }
        const unsigned old = xb_add(&bar[XB_XSUB(b.x)], 1u);
        const unsigned gen = old / nloc;
        if (old + 1u == (gen + 1u) * nloc) {
            __builtin_amdgcn_fence(__ATOMIC_RELEASE, "agent");
            asm volatile("s_waitcnt vmcnt(0)" ::: "memory");
            const unsigned og = xb_add(&bar[XB_TOP], 1u);
            const unsigned tg = og / nx;
            if (og + 1u == (tg + 1u) * nx) xb_add(&bar[XB_TOPGEN], 1u);
            else XB_SPIN(xb_ld(&bar[XB_TOPGEN]) == tg, bar);
            __builtin_amdgcn_fence(__ATOMIC_ACQUIRE, "agent");
            xb_add(&bar[XB_XGEN(b.x)], 1u);
            asm volatile("s_waitcnt vmcnt(0)" ::: "memory");
        } else {
            XB_SPIN(xb_ld(&bar[XB_XGEN(b.x)]) == gen, bar);
            __builtin_amdgcn_fence(__ATOMIC_ACQUIRE, "agent");
            asm volatile("s_waitcnt vmcnt(0)" ::: "memory");
        }
    }
    __syncthreads();
}

__device__ __forceinline__ void side_gemm_ba(const Params& p, LAS unsigned char* lds) {
    const int tid = threadIdx.x, l = tid & 63, w = __builtin_amdgcn_readfirstlane(tid >> 6), lr = l & 15, lq = l >> 4;
    const bf16_t* xn = (const bf16_t*)(p.ws + WS_XN); const bf16_t* wba = (const bf16_t*)(p.ws + WS_WBA); float* ba = (float*)(p.ws + WS_BA);
    LAS f32x4* red = (LAS f32x4*)lds;
    for (int rb = blockIdx.x; rb < MTOK / 32; rb += gridDim.x) {
        f32x4 acc[2][2];
#pragma unroll
        for (int i = 0; i < 2; ++i)
#pragma unroll
            for (int j = 0; j < 2; ++j) acc[i][j] = (f32x4){0.f, 0.f, 0.f, 0.f};
#pragma unroll 2
        for (int ks = 0; ks < 8; ++ks) {
            bf16x8 af[2], bfr[2];
#pragma unroll
            for (int i = 0; i < 2; ++i) { af[i] = *(const bf16x8*)(xn + (size_t)(32 * rb + 16 * i + lr) * DM + 256 * w + 32 * ks + 8 * lq); bfr[i] = *(const bf16x8*)(wba + (size_t)(16 * i + lr) * DM + 256 * w + 32 * ks + 8 * lq); }
#pragma unroll
            for (int i = 0; i < 2; ++i)
#pragma unroll
                for (int j = 0; j < 2; ++j) acc[i][j] = MFMA16(af[i], bfr[j], acc[i][j]);
        }
        __syncthreads();
#pragma unroll
        for (int i = 0; i < 2; ++i)
#pragma unroll
            for (int j = 0; j < 2; ++j) red[(w * 4 + i * 2 + j) * 64 + l] = acc[i][j];
        __syncthreads();
        if (w < 4) { const int ti = w >> 1, tj = w & 1; f32x4 sacc = (f32x4){0.f, 0.f, 0.f, 0.f};
#pragma unroll
            for (int ww = 0; ww < 8; ++ww) sacc = sacc + red[(ww * 4 + w) * 64 + l];
#pragma unroll
            for (int r = 0; r < 4; ++r) ba[(size_t)(32 * rb + 16 * ti + 4 * lq + r) * 32 + 16 * tj + lr] = sacc[r]; }
    }
    __syncthreads();
}

__global__ void __launch_bounds__(512, 2) hybrid_fwd(Params p) {
    extern __shared__ __attribute__((aligned(16))) unsigned char smem[];
    LAS unsigned char* lds = (LAS unsigned char*)smem;
    cg::grid_group grid = cg::this_grid();
    unsigned char* ws = p.ws;
    const int lo = p.ph_lo, hi = p.ph_hi, G = gridDim.x, c = blockIdx.x;
#define IN(k) (lo <= (k) && (k) < hi)
    volatile LAS unsigned* xst = (volatile LAS unsigned*)(lds + 147440);
    if (threadIdx.x == 0) { xst[0] = 0u; xst[1] = 0u; }
    __syncthreads();
    XcdBarrier xb; xb.bar = (unsigned*)(ws + WS_BAR); xb.x = 0; xb.st = xst;
    if (hi - lo > 1) xb = xcd_barrier_post((unsigned*)(ws + WS_BAR), xst);
    if (hi - lo > 1) grid.sync();
#define SEAM(k) do { if (IN(k) && IN((k) + 1)) xcd_barrier(xb); } while (0)
#ifndef DUP_MASK
#define DUP_MASK 0
#endif
#define NREP(k) (((DUP_MASK >> (k)) & 1) ? 2 : 1)
    if (IN(0)) for (int rep = 0; rep < NREP(0); ++rep) { phase0(p, lds); __syncthreads(); }
    SEAM(0);
#ifdef EXTRA_SYNCS
    for (int e = 0; e < EXTRA_SYNCS; ++e) grid.sync();
#endif
    if (IN(1)) for (int rep = 0; rep < NREP(1); ++rep) { side_gemm_ba(p, lds); pg8::Gemm g{(const bf16_t*)(ws + WS_XN), (const bf16_t*)(ws + WS_WIN), MTOK, LDP, DM, DM}; pg8::StaticOrder S; S.init(MTOK, LDP, G, c);
        EpiProj E{(bf16_t*)(ws + WS_PROJ), LDP}; pg8::gemm_phase<EpiProj, pg8::StaticOrder>(lds, g, S, E, nullptr); }
    SEAM(1);
    if (IN(2)) { for (int rep = 0; rep < NREP(2); ++rep) { phase2(p, lds); __syncthreads(); } if (!(IN(3) && G > 64)) phase2_mixer(p, c, G); }
    SEAM(2);
    if (IN(3)) { if (NREP(3) == 2) { phase3(p, lds, (bf16_t*)p.out, DM); __syncthreads(); } phase3(p, lds, (bf16_t*)(ws + WS_PROJ) + OFF_Z, LDP);
        if (G > 64) { if (c >= 64) { convert_late_weights(p, lds, (c - 64) * 8 + (int)(threadIdx.x >> 6), (G - 64) * 8); if (IN(2)) phase2_mixer(p, c - 64, G - 64); } }
        else { __syncthreads(); convert_late_weights(p, lds, c * 8 + (int)(threadIdx.x >> 6), G * 8); } }
    SEAM(3);
    if (IN(4)) {
        { pg8::Gemm g{(const bf16_t*)(ws + WS_PROJ) + OFF_Z, (const bf16_t*)(ws + WS_WA), MTOK, DM, DM, LDP}; pg8::StaticOrder S; S.init(MTOK, DM, G, c);
          EpiMergeA E{(float*)(ws + WS_MA), (const bf16_t*)(ws + WS_PROJ)}; pg8::gemm_phase<EpiMergeA, pg8::StaticOrder>(lds, g, S, E, nullptr); }
        __syncthreads();
        { pg8::Gemm g{(const bf16_t*)(ws + WS_PROJ) + OFF_SB, (const bf16_t*)(ws + WS_WB), MTOK, DM, DM, LDP}; pg8::StaticOrder S; S.init(MTOK, DM, G, c);
          EpiMergeB E{(const float*)(ws + WS_MA), (bf16_t*)(ws + WS_MB), (const bf16_t*)(ws + WS_PROJ)}; pg8::gemm_phase<EpiMergeB, pg8::StaticOrder>(lds, g, S, E, nullptr); }
    }
    SEAM(4);
    if (IN(5)) { pg8::Gemm g{(const bf16_t*)(ws + WS_MB), (const bf16_t*)(ws + WS_WO), MTOK, DM, DM, DM}; pg8::StaticOrder S; S.init(MTOK, DM, G, c);
        EpiResid E{p.x, (float*)(ws + WS_H1F), (bf16_t*)(ws + WS_H1B), (float*)(ws + WS_RSQ1)}; pg8::gemm_phase<EpiResid, pg8::StaticOrder>(lds, g, S, E, nullptr); }
    SEAM(5);
    if (IN(6)) { pg8::Gemm g{(const bf16_t*)(ws + WS_H1B), (const bf16_t*)(ws + WS_WGU), MTOK, 2 * DFF, DM, DM}; pg8::StaticOrder S; S.init(MTOK, 2 * DFF, G, c);
        EpiFFN E{(bf16_t*)(ws + WS_FF), (const float*)(ws + WS_RSQ1)}; pg8::gemm_phase<EpiFFN, pg8::StaticOrder>(lds, g, S, E, nullptr); }
    SEAM(6);
    if (IN(7)) { pg8::Gemm g{(const bf16_t*)(ws + WS_FF), (const bf16_t*)(ws + WS_WD), MTOK, DM, DFF, DFF}; pg8::StaticOrder S; S.init(MTOK, DM, G, c);
        EpiResid E{(const float*)(ws + WS_H1F), p.out, nullptr, nullptr}; pg8::gemm_phase<EpiResid, pg8::StaticOrder>(lds, g, S, E, nullptr); }
    SEAM(7);
    if (IN(8)) phase8(p);
#undef IN
#undef SEAM
}

extern "C" void kernel_launch(void* const* d_in, const int* in_sizes, int n_in, void* d_out, int out_size, void* d_ws, size_t ws_size, hipStream_t stream) {
    constexpr int LDS_BYTES = 147456;
    static int grid = 0;
    if (grid == 0) {
        if (n_in != 16 || out_size != MTOK * DM || ws_size < WS_END) { fprintf(stderr, "kernel_launch: unexpected shapes (n_in %d out %d ws %zu need %zu)\n", n_in, out_size, ws_size, (size_t)WS_END); grid = -1; return; }
        int dev = 0, cus = 0, per_cu = 0;
        hipGetDevice(&dev); hipDeviceGetAttribute(&cus, hipDeviceAttributeMultiprocessorCount, dev);
        if (hipFuncSetAttribute((const void*)hybrid_fwd, hipFuncAttributeMaxDynamicSharedMemorySize, LDS_BYTES) != hipSuccess) { fprintf(stderr, "kernel_launch: hipFuncSetAttribute failed\n"); grid = -1; return; }
        if (hipOccupancyMaxActiveBlocksPerMultiprocessor(&per_cu, (const void*)hybrid_fwd, 512, LDS_BYTES) != hipSuccess || per_cu < 1) { fprintf(stderr, "kernel_launch: occupancy query says %d blocks per CU\n", per_cu); per_cu = 1; }
        (void)hipGetLastError();
        grid = cus * 1;
        fprintf(stderr, "kernel_launch: cus %d per_cu %d grid %d ws %zu need %zu\n", cus, per_cu, grid, ws_size, (size_t)WS_END);
    }
    if (grid < 0) return;
    Params p{};
    p.x = (const float*)d_in[0]; p.ln_mix_g = (const float*)d_in[1]; p.w_in = (const float*)d_in[2]; p.conv_qkv_w = (const float*)d_in[3]; p.A_log = (const float*)d_in[4]; p.dt_bias = (const float*)d_in[5];
    p.gdn_norm_g = (const float*)d_in[6]; p.w_proj_a = (const float*)d_in[7]; p.conv_sc_w = (const float*)d_in[8]; p.w_proj_b = (const float*)d_in[9]; p.w_out = (const float*)d_in[10]; p.ln_ffn_g = (const float*)d_in[11];
    p.w_gate = (const float*)d_in[12]; p.w_up = (const float*)d_in[13]; p.w_down = (const float*)d_in[14]; p.ln_final_g = (const float*)d_in[15];
    p.out = (float*)d_out; p.ws = (unsigned char*)d_ws;
#if N_LAUNCHES == 1
    p.ph_lo = 0; p.ph_hi = NPHASE;
    (void)hipMemsetAsync((char*)d_ws + WS_BAR, 0, XCD_BAR_WORDS * 4, stream);
    void* args[] = {&p};
    hipError_t e = hipLaunchCooperativeKernel((const void*)hybrid_fwd, dim3(grid), dim3(512), args, LDS_BYTES, stream);
    if (e != hipSuccess) fprintf(stderr, "kernel_launch: cooperative launch failed: %s (grid %d)\n", hipGetErrorString(e), grid);
#else
    for (int k = 0; k < NPHASE; ++k) { p.ph_lo = k; p.ph_hi = k + 1; hipLaunchKernelGGL(hybrid_fwd, dim3(grid), dim3(512), LDS_BYTES, stream, p); }
#endif
}
```
